# Optimizing an MI355X kernel written in HIP

```python
import math
import jax
import jax.numpy as jnp
from jax import lax
import numpy as np

D_MODEL = 1024
BATCH = 2
SEQ = 8192
DEPTH = 2
DEC_BATCH = 8
DEC_SEQ = 8192
PAST_LEN = 128

HEAD_DIM = 64
N_HEADS_A = 4
DIFF_DIM = HEAD_DIM // 2
N_HEADS_B = 4
N_HEADS_C = 4
N_HEADS_D = 4
N_KV_D = 2
BRANCH_W = 4 * HEAD_DIM
N_BRANCH = 4
GRID_W = 64
NA_ROWS_MAX = 8
NA_COLS = 16
C_PATTERNS = ((128, 1), (512, 4), (2048, 16))
ROPE_THETA = 500000.0
ROPE_FRACTION = 4
AXIAL_THETA = 10000.0
Q_BLOCK = 128
D_FF = 2816
EPS = 1e-6
NEG_INF = -1e30
IN_SPLITS = (
    N_HEADS_A * HEAD_DIM, N_HEADS_A * HEAD_DIM, N_HEADS_A * HEAD_DIM,
    N_HEADS_B * HEAD_DIM, N_HEADS_B * HEAD_DIM, N_HEADS_B * HEAD_DIM,
    N_HEADS_C * HEAD_DIM, N_HEADS_C * HEAD_DIM, N_HEADS_C * HEAD_DIM,
    N_HEADS_D * HEAD_DIM, N_KV_D * HEAD_DIM, N_KV_D * HEAD_DIM,
    N_BRANCH * D_MODEL,
)
IN_COLS = 9 * BRANCH_W + N_HEADS_D * HEAD_DIM + 2 * N_KV_D * HEAD_DIM + N_BRANCH * D_MODEL

kernel_name = "hybrid_gated_encoder_4mixer"


def _rms_norm(x, g):
    xf = x.astype(jnp.float32)
    y = xf * lax.rsqrt(jnp.mean(xf * xf, axis=-1, keepdims=True) + EPS)
    return (y * g.astype(jnp.float32)).astype(x.dtype)


def _rope(x, pos, theta):
    half = x.shape[-1] // 2
    inv = jnp.exp(-math.log(theta) * jnp.arange(half, dtype=jnp.float32) / half)
    ang = pos.astype(jnp.float32)[:, None] * inv[None, :]
    ang = ang.reshape((pos.shape[0],) + (1,) * (x.ndim - 3) + (half,))
    cos, sin = jnp.cos(ang), jnp.sin(ang)
    xf = x.astype(jnp.float32)
    x1, x2 = xf[..., :half], xf[..., half:]
    return jnp.concatenate([x1 * cos - x2 * sin, x2 * cos + x1 * sin], axis=-1).astype(x.dtype)


def _partial_rope(x, pos):
    nr = x.shape[-1] // ROPE_FRACTION
    return jnp.concatenate([_rope(x[..., :nr], pos, ROPE_THETA), x[..., nr:]], axis=-1)


def _axial_rope(x, pos):
    half = x.shape[-1] // 2
    return jnp.concatenate([_rope(x[..., :half], pos // GRID_W, AXIAL_THETA),
                            _rope(x[..., half:], pos % GRID_W, AXIAL_THETA)], axis=-1)


def _sweep_query_blocks(q, fn):
    B, S = q.shape[:2]
    nb = S // Q_BLOCK
    qb = jnp.moveaxis(q.reshape((B, nb, Q_BLOCK) + q.shape[2:]), 1, 0)
    out = lax.map(fn, qb)
    return jnp.moveaxis(out, 0, 1).reshape((B, S) + out.shape[3:])


def _diff_attention(q, k, v, lam_vecs, subln_g, lam_init, pos):
    B, S, H = q.shape[:3]
    q = _partial_rope(q, pos)
    k = _partial_rope(k, pos)
    lv = lam_vecs.astype(jnp.float32)
    lam = jnp.exp(jnp.sum(lv[0] * lv[1])) - jnp.exp(jnp.sum(lv[2] * lv[3])) + lam_init
    scale = DIFF_DIM ** -0.5

    def block(qb):
        s = jnp.einsum("bqhcd,bkhcd->bhcqk", qb, k, preferred_element_type=jnp.float32) * scale
        p = jax.nn.softmax(s, axis=-1)
        a = p[:, :, 0] - lam * p[:, :, 1]
        return jnp.einsum("bhqk,bkhd->bqhd", a.astype(v.dtype), v)

    o = _sweep_query_blocks(q, block)
    o = _rms_norm(o, subln_g) * (1.0 - lam_init)
    return o.reshape(B, S, H * HEAD_DIM)


def _neighbourhood_attention(q, k, v, rpb):
    B, S, H, dh = q.shape
    rows = S // GRID_W
    kr = min(NA_ROWS_MAX, rows)
    r = jnp.arange(rows)
    row_idx = jnp.clip(r - kr // 2, 0, rows - kr)[:, None] + jnp.arange(kr)[None, :]
    c = jnp.arange(GRID_W)
    col_start = jnp.clip(c - NA_COLS // 2, 0, GRID_W - NA_COLS)
    col_in = (c[None, :] >= col_start[:, None]) & (c[None, :] < col_start[:, None] + NA_COLS)
    dr = row_idx - r[:, None] + NA_ROWS_MAX - 1
    dc = jnp.clip(c[None, :] - c[:, None] + NA_COLS - 1, 0, 2 * NA_COLS - 2)
    bias = rpb.astype(jnp.float32)[:, dr][:, :, :, dc]
    bias = jnp.where(col_in[None, None, None], bias, NEG_INF).transpose(1, 0, 3, 2, 4)
    qg = q.reshape(B, rows, GRID_W, H, dh)
    kg = jnp.take(k.reshape(B, rows, GRID_W, H, dh), row_idx, axis=1)
    vg = jnp.take(v.reshape(B, rows, GRID_W, H, dh), row_idx, axis=1)
    s = jnp.einsum("brchd,brkmhd->brhckm", qg, kg, preferred_element_type=jnp.float32) * dh ** -0.5 + bias
    p = jax.nn.softmax(s.reshape(B, rows, H, GRID_W, kr * GRID_W), axis=-1).reshape(s.shape)
    o = jnp.einsum("brhckm,brkmhd->brchd", p.astype(v.dtype), vg)
    return o.reshape(B, S, H * dh)


def _to_sub(x, d):
    B, S = x.shape[:2]
    r = x.reshape((B, S // d, d) + x.shape[2:])
    return jnp.moveaxis(r, 2, 1).reshape((B * d, S // d) + x.shape[2:])


def _from_sub(x, d, B):
    L = x.shape[1]
    r = x.reshape((B, d, L) + x.shape[2:])
    return jnp.moveaxis(r, 1, 2).reshape((B, L * d) + x.shape[2:])


def _banded_attention(q, k, v, half):
    N, L, H, dh = q.shape
    nb = -(-L // Q_BLOCK)
    lq = nb * Q_BLOCK
    kw = Q_BLOCK + 2 * half
    qb = jnp.pad(q, ((0, 0), (0, lq - L), (0, 0), (0, 0))).reshape(N, nb, Q_BLOCK, H, dh)
    pad = ((0, 0), (half, lq - L + half), (0, 0), (0, 0))
    idx = jnp.arange(nb)[:, None] * Q_BLOCK + jnp.arange(kw)[None, :]
    kb = jnp.take(jnp.pad(k, pad), idx, axis=1)
    vb = jnp.take(jnp.pad(v, pad), idx, axis=1)
    s = jnp.einsum("nbqhd,nbkhd->nbhqk", qb, kb, preferred_element_type=jnp.float32) * dh ** -0.5
    key_pos = idx - half
    q_pos = jnp.arange(nb)[:, None] * Q_BLOCK + jnp.arange(Q_BLOCK)[None, :]
    rel = key_pos[:, None, :] - q_pos[:, :, None]
    valid = (jnp.abs(rel) <= half) & (key_pos[:, None, :] >= 0) & (key_pos[:, None, :] < L)
    s = jnp.where(valid[None, :, None], s, NEG_INF)
    lse = jax.nn.logsumexp(s, axis=-1)
    p = jnp.exp(s - lse[..., None])
    o = jnp.einsum("nbhqk,nbkhd->nbqhd", p.astype(v.dtype), vb).reshape(N, lq, H, dh)[:, :L]
    lse = jnp.swapaxes(lse, 2, 3).reshape(N, lq, H)[:, :L]
    return o, lse


def _dilated_attention(q, k, v, pos):
    B, S, H, dh = q.shape
    q = _partial_rope(q, pos)
    k = _partial_rope(k, pos)
    outs, lses = [], []
    for window, dil in C_PATTERNS:
        half = window // (2 * dil)
        o, lse = _banded_attention(_to_sub(q, dil), _to_sub(k, dil), _to_sub(v, dil), half)
        outs.append(_from_sub(o, dil, B))
        lses.append(_from_sub(lse, dil, B))
    wgt = jax.nn.softmax(jnp.stack(lses, axis=0), axis=0)
    o = jnp.einsum("nbsh,nbshd->bshd", wgt, jnp.stack(outs, axis=0).astype(jnp.float32))
    return o.astype(v.dtype).reshape(B, S, H * dh)


def _axial_gqa(q, k, v, g_q, g_k, pos):
    B, S, H, dh = q.shape
    q = _axial_rope(_rms_norm(q, g_q), pos)
    k = _axial_rope(_rms_norm(k, g_k), pos)
    q = q.reshape(B, S, N_KV_D, H // N_KV_D, dh)
    scale = dh ** -0.5

    def block(qb):
        s = jnp.einsum("bqkgd,bskd->bkgqs", qb, k, preferred_element_type=jnp.float32) * scale
        p = jax.nn.softmax(s, axis=-1)
        return jnp.einsum("bkgqs,bskd->bqkgd", p.astype(v.dtype), v)

    o = _sweep_query_blocks(q, block)
    return o.reshape(B, S, H * dh)


def _layer(x, pos, lam_init, norm_attn, w_in, diff_lambda, diff_subln, na_rpb, qk_norm,
           w_branch, w_out, norm_mlp, w_up, conv_w, conv_b, w_down):
    B, S, _ = x.shape
    h = _rms_norm(x, norm_attn)
    proj = h @ w_in
    cuts = np.cumsum(IN_SPLITS)[:-1].tolist()
    aq, ak, av, bq, bk, bv, cq, ck, cv, dq, dk, dv, gate = jnp.split(proj, cuts, axis=-1)
    o_a = _diff_attention(aq.reshape(B, S, N_HEADS_A, 2, DIFF_DIM), ak.reshape(B, S, N_HEADS_A, 2, DIFF_DIM),
                          av.reshape(B, S, N_HEADS_A, HEAD_DIM), diff_lambda, diff_subln, lam_init, pos)
    o_b = _neighbourhood_attention(bq.reshape(B, S, N_HEADS_B, HEAD_DIM), bk.reshape(B, S, N_HEADS_B, HEAD_DIM),
                                   bv.reshape(B, S, N_HEADS_B, HEAD_DIM), na_rpb)
    o_c = _dilated_attention(cq.reshape(B, S, N_HEADS_C, HEAD_DIM), ck.reshape(B, S, N_HEADS_C, HEAD_DIM),
                             cv.reshape(B, S, N_HEADS_C, HEAD_DIM), pos)
    o_d = _axial_gqa(dq.reshape(B, S, N_HEADS_D, HEAD_DIM), dk.reshape(B, S, N_KV_D, HEAD_DIM),
                     dv.reshape(B, S, N_KV_D, HEAD_DIM), qk_norm[0], qk_norm[1], pos)
    gates = jax.nn.sigmoid(gate.reshape(B, S, N_BRANCH, D_MODEL))
    merged = gates[:, :, 0] * (o_a @ w_branch[0])
    merged = merged + gates[:, :, 1] * (o_b @ w_branch[1])
    merged = merged + gates[:, :, 2] * (o_c @ w_branch[2])
    merged = merged + gates[:, :, 3] * (o_d @ w_branch[3])
    x = x + merged @ w_out
    h = _rms_norm(x, norm_mlp)
    u = h @ w_up
    up = jnp.pad(u, ((0, 0), (1, 1), (0, 0)))
    u = up[:, :-2] * conv_w[0] + up[:, 1:-1] * conv_w[1] + up[:, 2:] * conv_w[2] + conv_b
    val, gt = jnp.split(u, 2, axis=-1)
    return x + (jax.nn.gelu(gt, approximate=False) * val) @ w_down


def _trunk(x, norm_attn, w_in, diff_lambda, diff_subln, na_rpb, qk_norm, w_branch, w_out,
           norm_mlp, w_up, conv_w, conv_b, w_down, norm_final):
    pos = jnp.arange(x.shape[1], dtype=jnp.int32)
    for l in range(DEPTH):
        lam_init = 0.8 - 0.6 * math.exp(-0.3 * l)
        x = _layer(x, pos, lam_init, norm_attn[l], w_in[l], diff_lambda[l], diff_subln[l], na_rpb[l],
                   qk_norm[l], w_branch[l], w_out[l], norm_mlp[l], w_up[l], conv_w[l], conv_b[l], w_down[l])
    return _rms_norm(x, norm_final)


def setup_inputs(seed: int = 0) -> dict:
    key = jax.random.key(seed)
    ks = jax.random.split(key, 16)
    f32 = jnp.float32
    nrm = lambda k, shape, s: jax.random.normal(k, shape, f32) * s
    return {
        "x_prompt": nrm(ks[0], (BATCH, SEQ, D_MODEL), 1.0),
        "x_sample": nrm(ks[1], (DEC_BATCH, DEC_SEQ, D_MODEL), 1.0),
        "norm_attn": 1.0 + nrm(ks[2], (DEPTH, D_MODEL), 0.02),
        "w_in": nrm(ks[3], (DEPTH, D_MODEL, IN_COLS), D_MODEL ** -0.5),
        "diff_lambda": nrm(ks[4], (DEPTH, 4, DIFF_DIM), 0.1),
        "diff_subln": 1.0 + nrm(ks[5], (DEPTH, HEAD_DIM), 0.02),
        "na_rpb": nrm(ks[6], (DEPTH, N_HEADS_B, 2 * NA_ROWS_MAX - 1, 2 * NA_COLS - 1), 0.1),
        "qk_norm": 1.0 + nrm(ks[7], (DEPTH, 2, HEAD_DIM), 0.02),
        "w_branch": nrm(ks[8], (DEPTH, N_BRANCH, BRANCH_W, D_MODEL), BRANCH_W ** -0.5),
        "w_out": nrm(ks[9], (DEPTH, D_MODEL, D_MODEL), D_MODEL ** -0.5),
        "norm_mlp": 1.0 + nrm(ks[10], (DEPTH, D_MODEL), 0.02),
        "w_up": nrm(ks[11], (DEPTH, D_MODEL, 2 * D_FF), D_MODEL ** -0.5),
        "conv_w": nrm(ks[12], (DEPTH, 3, 2 * D_FF), 3 ** -0.5),
        "conv_b": nrm(ks[13], (DEPTH, 2 * D_FF), 0.02),
        "w_down": nrm(ks[14], (DEPTH, D_FF, D_MODEL), D_FF ** -0.5),
        "norm_final": 1.0 + nrm(ks[15], (D_MODEL,), 0.02),
    }


def reference(x_prompt, x_sample, norm_attn, w_in, diff_lambda, diff_subln, na_rpb, qk_norm, w_branch,
              w_out, norm_mlp, w_up, conv_w, conv_b, w_down, norm_final):
    y_prompt = _trunk(x_prompt, norm_attn, w_in, diff_lambda, diff_subln, na_rpb, qk_norm, w_branch, w_out,
                      norm_mlp, w_up, conv_w, conv_b, w_down, norm_final)
    y_sample = _trunk(x_sample, norm_attn, w_in, diff_lambda, diff_subln, na_rpb, qk_norm, w_branch, w_out,
                      norm_mlp, w_up, conv_w, conv_b, w_down, norm_final)
    return (y_prompt, y_sample)
```

```cpp
#include <hip/hip_runtime.h>
#include <hip/hip_cooperative_groups.h>
#include <cstdio>
#include <cmath>
namespace cg = cooperative_groups;

#ifndef MEGA
#define MEGA 0
#endif

#define DEVI __device__ __forceinline__
#define LAS __attribute__((address_space(3)))
typedef unsigned short bf16;
typedef short bf16x8 __attribute__((ext_vector_type(8)));
typedef short s16x4 __attribute__((ext_vector_type(4)));
typedef float f32x16 __attribute__((ext_vector_type(16)));
typedef float f32x4 __attribute__((ext_vector_type(4)));
typedef float f32x2_t __attribute__((ext_vector_type(2)));
typedef __bf16 bf16x2_t __attribute__((ext_vector_type(2)));
typedef unsigned u32x4 __attribute__((ext_vector_type(4)));
typedef unsigned u32x2 __attribute__((ext_vector_type(2)));
typedef LAS char lchar;

constexpr int DM = 1024, SEQ = 8192, NSEQ = 10, MTOK = NSEQ * SEQ, NQKV = 2816, INC = 6912, DFF = 2816, NUP = 5632;
constexpr float LOG2E = 1.4426950408889634f;
constexpr float EPS = 1e-6f;
constexpr int LDS_BYTES = 73728;
constexpr int CP = 132;

constexpr size_t SZ_WIN = (size_t)2 * INC * DM * 2, SZ_WB = (size_t)2 * 4 * DM * 256 * 2, SZ_WOUT = (size_t)2 * DM * DM * 2,
                 SZ_WUP = (size_t)2 * NUP * DM * 2, SZ_WDN = (size_t)2 * DM * DFF * 2;
constexpr size_t WS_WIN = 0, WS_WB = WS_WIN + SZ_WIN, WS_WOUT = WS_WB + SZ_WB, WS_WUP = WS_WOUT + SZ_WOUT, WS_WDN = WS_WUP + SZ_WUP;
constexpr size_t WS_H = WS_WDN + SZ_WDN;
constexpr size_t WS_O = WS_H + (size_t)MTOK * DM * 2;
constexpr size_t WS_QKV = WS_O + (size_t)MTOK * DM * 2;
constexpr size_t WS_END = WS_QKV + (size_t)MTOK * NQKV * 2;

struct Params {
  const float *xp, *xs, *norm_attn, *w_in, *diff_lambda, *diff_subln, *na_rpb, *qk_norm, *w_branch, *w_out, *norm_mlp, *w_up, *conv_w, *conv_b, *w_down, *norm_final;
  float* out; char* ws;
  double invA[4], invC[8], invD[16];
  float lam_init[2]; int phase_lo, phase_hi;
};

DEVI unsigned cvtpk(float lo, float hi) { f32x2_t v = {lo, hi}; bf16x2_t b = __builtin_convertvector(v, bf16x2_t); return __builtin_bit_cast(unsigned, b); }
DEVI float bf2f(unsigned short h) { return __uint_as_float(((unsigned)h) << 16); }
DEVI f32x16 mfma(bf16x8 a, bf16x8 b, f32x16 c) { return __builtin_amdgcn_mfma_f32_32x32x16_bf16(a, b, c, 0, 0, 0); }
DEVI int crow(int r, int g) { return (r & 3) + 8 * (r >> 2) + 4 * g; }
DEVI float ex2(float x) { return __builtin_amdgcn_exp2f(x); }
DEVI s16x4 trread(const lchar* p) { return __builtin_bit_cast(s16x4, __builtin_amdgcn_ds_read_tr16_b64_v4i16((LAS s16x4*)p)); }
DEVI int otid() { int t = threadIdx.x; asm volatile("" : "+v"(t)); return t; }
DEVI float wave_sum(float v) {
#pragma unroll
  for (int o = 1; o < 64; o <<= 1) v += __shfl_xor(v, o);
  return v;
}

template <int NI>
DEVI void gemm_mainloop(f32x16 (&acc)[2][NI], lchar* lds, const bf16* __restrict__ A, int lda, int arow0, int alo, int ahi,
                        const bf16* __restrict__ B, int ldb, int brow0, int brow1, int K) {
  const int tid = otid(), lane = tid & 63, wave = tid >> 6, wr = wave >> 1, wc = wave & 1, l32 = lane & 31, g = lane >> 5;
  const int kc = tid & 7, r0 = tid >> 3;
  constexpr int NBI = 2 * NI;
  int offA[4], offB[NBI];
#pragma unroll
  for (int i = 0; i < 4; ++i) {
    const int r = r0 + 32 * i;
    int ar = arow0 + r; ar = ar < alo ? alo : (ar > ahi ? ahi : ar);
    offA[i] = ar * lda + kc * 8;
  }
#pragma unroll
  for (int i = 0; i < NBI; ++i) {
    const int r = r0 + 32 * i;
    const int br = (r < 64) ? brow0 + r : brow1 + r - 64;
    offB[i] = br * ldb + kc * 8;
  }
  u32x4 ra[4], rb[NBI];
#pragma unroll
  for (int i = 0; i < 4; ++i) ra[i] = *(const u32x4*)(A + offA[i]);
#pragma unroll
  for (int i = 0; i < NBI; ++i) rb[i] = *(const u32x4*)(B + offB[i]);
  const int stoff = r0 * 144 + kc * 16;
#pragma unroll
  for (int i = 0; i < 4; ++i) *(LAS u32x4*)(lds + stoff + i * 4608) = ra[i];
#pragma unroll
  for (int i = 0; i < NBI; ++i) *(LAS u32x4*)(lds + 18432 + stoff + i * 4608) = rb[i];
  __syncthreads();
  const int nk = K >> 6;
  const int aoff = (wr * 64 + l32) * 144 + g * 16, boff = 18432 + (wc * 32 * NI + l32) * 144 + g * 16;
  for (int kt = 0; kt < nk; ++kt) {
    const int buf = (kt & 1) * 36864;
    const bool more = (kt + 1 < nk);
    if (more) {
      const int k0 = (kt + 1) * 64;
#pragma unroll
      for (int i = 0; i < 4; ++i) ra[i] = *(const u32x4*)(A + offA[i] + k0);
#pragma unroll
      for (int i = 0; i < NBI; ++i) rb[i] = *(const u32x4*)(B + offB[i] + k0);
    }
#pragma unroll
    for (int ks = 0; ks < 4; ++ks) {
      const bf16x8 a0 = *(const LAS bf16x8*)(lds + buf + aoff + ks * 32), a1 = *(const LAS bf16x8*)(lds + buf + aoff + 4608 + ks * 32);
      bf16x8 bfr[NI];
#pragma unroll
      for (int ni = 0; ni < NI; ++ni) bfr[ni] = *(const LAS bf16x8*)(lds + buf + boff + ni * 4608 + ks * 32);
#pragma unroll
      for (int ni = 0; ni < NI; ++ni) { acc[0][ni] = mfma(a0, bfr[ni], acc[0][ni]); acc[1][ni] = mfma(a1, bfr[ni], acc[1][ni]); }
    }
    if (more) {
      const int nb = 36864 - buf;
#pragma unroll
      for (int i = 0; i < 4; ++i) *(LAS u32x4*)(lds + nb + stoff + i * 4608) = ra[i];
#pragma unroll
      for (int i = 0; i < NBI; ++i) *(LAS u32x4*)(lds + nb + 18432 + stoff + i * 4608) = rb[i];
    }
    __syncthreads();
  }
}

template <int NI>
DEVI void zero_acc(f32x16 (&acc)[2][NI]) {
#pragma unroll
  for (int a = 0; a < 2; ++a)
#pragma unroll
    for (int b = 0; b < NI; ++b)
#pragma unroll
      for (int r = 0; r < 16; ++r) acc[a][b][r] = 0.f;
}

template <int NI>
DEVI void acc_to_lds(const f32x16 (&acc)[2][NI], lchar* lds) {
  const int tid = otid(), lane = tid & 63, wave = tid >> 6, wr = wave >> 1, wc = wave & 1, l32 = lane & 31, g = lane >> 5;
  LAS float* Cs = (LAS float*)lds;
#pragma unroll
  for (int mi = 0; mi < 2; ++mi)
#pragma unroll
    for (int ni = 0; ni < NI; ++ni)
#pragma unroll
      for (int r = 0; r < 16; ++r) Cs[(wr * 64 + mi * 32 + crow(r, g)) * CP + wc * 32 * NI + ni * 32 + l32] = acc[mi][ni][r];
}

DEVI void transpose_item(const float* __restrict__ W, int K, int N, bf16* __restrict__ Wt, int item, lchar* lds) {
  const int nnb = N >> 6, kb = item / nnb, nb = item - kb * nnb, tid = otid();
  LAS float* t = (LAS float*)lds;
  __syncthreads();
#pragma unroll
  for (int i = 0; i < 16; ++i) { const int k = (tid >> 6) + 4 * i, n = tid & 63; t[k * 65 + n] = W[(size_t)(kb * 64 + k) * N + nb * 64 + n]; }
  __syncthreads();
#pragma unroll
  for (int i = 0; i < 2; ++i) {
    const int c = tid + 256 * i, n = c >> 3, kc = c & 7;
    float v[8];
#pragma unroll
    for (int j = 0; j < 8; ++j) v[j] = t[(kc * 8 + j) * 65 + n];
    u32x4 o; o.x = cvtpk(v[0], v[1]); o.y = cvtpk(v[2], v[3]); o.z = cvtpk(v[4], v[5]); o.w = cvtpk(v[6], v[7]);
    *(u32x4*)(Wt + (size_t)(nb * 64 + n) * K + kb * 64 + kc * 8) = o;
  }
}

DEVI void phase_weights(const Params& p, lchar* lds) {
  constexpr int I_IN = 16 * 108, I_B = 4 * 16, I_OUT = 16 * 16, I_UP = 16 * 88, I_DN = 44 * 16;
  constexpr int T_IN = 2 * I_IN, T_B = 8 * I_B, T_OUT = 2 * I_OUT, T_UP = 2 * I_UP, T_DN = 2 * I_DN;
  constexpr int TOTAL = T_IN + T_B + T_OUT + T_UP + T_DN;
  for (int it = blockIdx.x; it < TOTAL; it += gridDim.x) {
    int r = it;
    if (r < T_IN) { const int l = r / I_IN; transpose_item(p.w_in + (size_t)l * DM * INC, DM, INC, (bf16*)(p.ws + WS_WIN) + (size_t)l * INC * DM, r - l * I_IN, lds); continue; }
    r -= T_IN;
    if (r < T_B) { const int lb = r / I_B; transpose_item(p.w_branch + (size_t)lb * 256 * DM, 256, DM, (bf16*)(p.ws + WS_WB) + (size_t)lb * DM * 256, r - lb * I_B, lds); continue; }
    r -= T_B;
    if (r < T_OUT) { const int l = r / I_OUT; transpose_item(p.w_out + (size_t)l * DM * DM, DM, DM, (bf16*)(p.ws + WS_WOUT) + (size_t)l * DM * DM, r - l * I_OUT, lds); continue; }
    r -= T_OUT;
    if (r < T_UP) { const int l = r / I_UP; transpose_item(p.w_up + (size_t)l * DM * NUP, DM, NUP, (bf16*)(p.ws + WS_WUP) + (size_t)l * NUP * DM, r - l * I_UP, lds); continue; }
    r -= T_UP;
    { const int l = r / I_DN; transpose_item(p.w_down + (size_t)l * DFF * DM, DFF, DM, (bf16*)(p.ws + WS_WDN) + (size_t)l * DM * DFF, r - l * I_DN, lds); }
  }
}

DEVI void phase_norm(const Params& p, int mode, const float* __restrict__ gain) {
  const int lane = otid() & 63, gw = blockIdx.x * 4 + (otid() >> 6), ngw = gridDim.x * 4;
  bf16* H = (bf16*)(p.ws + WS_H);
  f32x4 gg[4];
#pragma unroll
  for (int j = 0; j < 4; ++j) gg[j] = ((const f32x4*)gain)[lane + 64 * j];
  for (int row = gw; row < MTOK; row += ngw) {
    const float* src = (mode == 0) ? (row < 2 * SEQ ? p.xp + (size_t)row * DM : p.xs + (size_t)(row - 2 * SEQ) * DM) : p.out + (size_t)row * DM;
    f32x4 v[4]; float ss = 0.f;
#pragma unroll
    for (int j = 0; j < 4; ++j) { v[j] = ((const f32x4*)src)[lane + 64 * j]; ss += (v[j].x * v[j].x + v[j].y * v[j].y) + (v[j].z * v[j].z + v[j].w * v[j].w); }
    ss = wave_sum(ss);
    const float rstd = 1.0f / sqrtf(ss * (1.0f / DM) + EPS);
    float* orow = p.out + (size_t)row * DM;
#pragma unroll
    for (int j = 0; j < 4; ++j) {
      if (mode == 0) ((f32x4*)orow)[lane + 64 * j] = v[j];
      const f32x4 y = v[j] * rstd * gg[j];
      if (mode == 2) ((f32x4*)orow)[lane + 64 * j] = y;
      else { u32x2 w; w.x = cvtpk(y.x, y.y); w.y = cvtpk(y.z, y.w); ((u32x2*)(H + (size_t)row * DM))[lane + 64 * j] = w; }
    }
  }
}

DEVI void rot(float& a, float& b, double t) {
  const float rv = (float)(t - __builtin_rint(t));
  const float cs = __builtin_amdgcn_cosf(rv), sn = __builtin_amdgcn_sinf(rv);
  const float x1 = a, x2 = b; a = x1 * cs - x2 * sn; b = x2 * cs + x1 * sn;
}

DEVI void phase_qkv(const Params& p, int layer, lchar* lds) {
  const bf16* H = (const bf16*)(p.ws + WS_H);
  const bf16* Wt = (const bf16*)(p.ws + WS_WIN) + (size_t)layer * INC * DM;
  bf16* QKV = (bf16*)(p.ws + WS_QKV);
  const int tid = otid();
  constexpr int NT = 22, TILES = (MTOK / 128) * NT;
  for (int tile = blockIdx.x; tile < TILES; tile += gridDim.x) {
    const int mt = tile / NT, nt = tile - mt * NT, m0 = mt * 128, n0 = nt * 128;
    f32x16 acc[2][2]; zero_acc<2>(acc);
    gemm_mainloop<2>(acc, lds, H, DM, m0, 0, MTOK - 1, Wt, DM, n0, n0 + 64, DM);
    acc_to_lds<2>(acc, lds);
    __syncthreads();
    {
      const LAS float* Cs = (const LAS float*)lds;
      const int row = tid & 127, grp = tid >> 7, G = nt * 2 + grp, grow = m0 + row, pos = grow & (SEQ - 1);
      float v[64];
#pragma unroll
      for (int i = 0; i < 16; ++i) { const f32x4 t = *(const LAS f32x4*)(Cs + row * CP + grp * 64 + 4 * i); v[4 * i] = t.x; v[4 * i + 1] = t.y; v[4 * i + 2] = t.z; v[4 * i + 3] = t.w; }
      const float qs = 0.125f * LOG2E;
      float sc = 1.f;
      if (G < 8) {
#pragma unroll
        for (int i = 0; i < 4; ++i) { const double t = (double)pos * p.invA[i]; rot(v[i], v[4 + i], t); rot(v[32 + i], v[36 + i], t); }
        if (G < 4) sc = 0.17677669529663687f * LOG2E;
      } else if (G >= 12 && G < 16) { sc = qs;
      } else if (G >= 24 && G < 32) {
#pragma unroll
        for (int i = 0; i < 8; ++i) { const double t = (double)pos * p.invC[i]; rot(v[i], v[8 + i], t); }
        if (G < 28) sc = qs;
      } else if (G >= 36 && G < 42) {
        const float* gq = p.qk_norm + layer * 128 + (G < 40 ? 0 : 64);
        float ss = 0.f;
#pragma unroll
        for (int i = 0; i < 64; ++i) ss += v[i] * v[i];
        const float rstd = 1.0f / sqrtf(ss * (1.0f / 64.0f) + EPS);
#pragma unroll
        for (int i = 0; i < 64; ++i) v[i] = v[i] * rstd * gq[i];
        const int pr = pos >> 6, pc = pos & 63;
#pragma unroll
        for (int i = 0; i < 16; ++i) { rot(v[i], v[16 + i], (double)pr * p.invD[i]); rot(v[32 + i], v[48 + i], (double)pc * p.invD[i]); }
        if (G < 40) sc = qs;
      }
      bf16* dst = QKV + (size_t)grow * NQKV + G * 64;
#pragma unroll
      for (int i = 0; i < 8; ++i) {
        u32x4 o; o.x = cvtpk(v[8 * i] * sc, v[8 * i + 1] * sc); o.y = cvtpk(v[8 * i + 2] * sc, v[8 * i + 3] * sc);
        o.z = cvtpk(v[8 * i + 4] * sc, v[8 * i + 5] * sc); o.w = cvtpk(v[8 * i + 6] * sc, v[8 * i + 7] * sc);
        ((u32x4*)dst)[i] = o;
      }
    }
    __syncthreads();
  }
}

template <int NKH>
DEVI void flash_update(f32x16 (&s)[NKH], float& m, float& l, f32x16 (&o)[2], const lchar* vb, int dhs, int lane) {
  float mx = s[0][0];
#pragma unroll
  for (int kh = 0; kh < NKH; ++kh)
#pragma unroll
    for (int r = 0; r < 16; ++r) mx = fmaxf(mx, s[kh][r]);
  mx = fmaxf(mx, __shfl_xor(mx, 32));
  const float mn = fmaxf(m, mx);
  const float alpha = ex2(m - mn);
  m = mn; l *= alpha;
#pragma unroll
  for (int dh = 0; dh < 2; ++dh)
#pragma unroll
    for (int r = 0; r < 16; ++r) o[dh][r] *= alpha;
  float ps = 0.f;
#pragma unroll
  for (int kh = 0; kh < NKH; ++kh)
#pragma unroll
    for (int r = 0; r < 16; ++r) { const float e = ex2(s[kh][r] - mn); s[kh][r] = e; ps += e; }
  l += ps;
  const int g = lane >> 5;
  const lchar* vp = vb + (4 * g + ((lane & 15) >> 2)) * 64 + ((lane >> 4) & 1) * 32 + (lane & 3) * 8;
#pragma unroll
  for (int kh = 0; kh < NKH; ++kh)
#pragma unroll
    for (int j = 0; j < 2; ++j) {
      u32x4 pw; pw.x = cvtpk(s[kh][8 * j], s[kh][8 * j + 1]); pw.y = cvtpk(s[kh][8 * j + 2], s[kh][8 * j + 3]);
      pw.z = cvtpk(s[kh][8 * j + 4], s[kh][8 * j + 5]); pw.w = cvtpk(s[kh][8 * j + 6], s[kh][8 * j + 7]);
      const bf16x8 pb = __builtin_bit_cast(bf16x8, pw);
#pragma unroll
      for (int dh = 0; dh < 2; ++dh) {
        const s16x4 lo = trread(vp + dh * dhs + (kh * 32 + 16 * j) * 64), hi = trread(vp + dh * dhs + (kh * 32 + 16 * j + 8) * 64);
        const bf16x8 a = {lo[0], lo[1], lo[2], lo[3], hi[0], hi[1], hi[2], hi[3]};
        o[dh] = mfma(a, pb, o[dh]);
      }
    }
}

DEVI void write_o(const f32x16 (&o)[2], float sc, bf16* dst, int g) {
#pragma unroll
  for (int dh = 0; dh < 2; ++dh)
#pragma unroll
    for (int r4 = 0; r4 < 4; ++r4) {
      u32x2 w; w.x = cvtpk(o[dh][4 * r4] * sc, o[dh][4 * r4 + 1] * sc); w.y = cvtpk(o[dh][4 * r4 + 2] * sc, o[dh][4 * r4 + 3] * sc);
      *(u32x2*)(dst + 32 * dh + 8 * r4 + 4 * g) = w;
    }
}

constexpr int AT_BUF = 17408, AT_V = 9216;
constexpr int AT_BIAS = 2 * AT_BUF;

struct KVRegs { u32x4 k[2], v[2]; };
DEVI void kv_load(KVRegs& r, const bf16* __restrict__ Kp, const bf16* __restrict__ Vp, int tok0, int tid) {
#pragma unroll
  for (int i = 0; i < 2; ++i) {
    const int c = tid + 256 * i, row = c >> 3, ch = c & 7;
    r.k[i] = *(const u32x4*)(Kp + (size_t)(tok0 + row) * NQKV + ch * 8);
    r.v[i] = *(const u32x4*)(Vp + (size_t)(tok0 + row) * NQKV + ch * 8);
  }
}
DEVI void kv_store(const KVRegs& r, lchar* buf, int tid) {
#pragma unroll
  for (int i = 0; i < 2; ++i) {
    const int c = tid + 256 * i, row = c >> 3, ch = c & 7;
    *(LAS u32x4*)(buf + row * 144 + ch * 16) = r.k[i];
    *(LAS u32x4*)(buf + AT_V + (ch >> 2) * 4096 + row * 64 + (ch & 3) * 16) = r.v[i];
  }
}

template <int NKS>
DEVI void attn_full_loop(const bf16* __restrict__ QKV, int seqbase, int tokq, int qcol, int kcol, int vcol, int kdimofs, float& m, float& l, f32x16 (&o)[2], lchar* lds) {
  const int tid = otid(), lane = tid & 63, l32 = lane & 31, g = lane >> 5;
  bf16x8 qf[NKS];
#pragma unroll
  for (int ks = 0; ks < NKS; ++ks) qf[ks] = *(const bf16x8*)(QKV + (size_t)tokq * NQKV + qcol + 16 * ks + 8 * g);
  const bf16* Kp = QKV + kcol;
  const bf16* Vp = QKV + vcol;
  KVRegs kr;
  __syncthreads();
  kv_load(kr, Kp, Vp, seqbase, tid);
  kv_store(kr, lds, tid);
  __syncthreads();
  constexpr int NT = SEQ / 64;
  for (int t = 0; t < NT; ++t) {
    lchar* buf = lds + (t & 1) * AT_BUF;
    if (t + 1 < NT) kv_load(kr, Kp, Vp, seqbase + (t + 1) * 64, tid);
    f32x16 s[2];
#pragma unroll
    for (int kh = 0; kh < 2; ++kh) {
#pragma unroll
      for (int r = 0; r < 16; ++r) s[kh][r] = 0.f;
#pragma unroll
      for (int ks = 0; ks < NKS; ++ks) {
        const bf16x8 a = *(const LAS bf16x8*)(buf + (kh * 32 + l32) * 144 + kdimofs + ks * 32 + g * 16);
        s[kh] = mfma(a, qf[ks], s[kh]);
      }
    }
    flash_update<2>(s, m, l, o, buf + AT_V, 4096, lane);
    if (t + 1 < NT) kv_store(kr, lds + ((t + 1) & 1) * AT_BUF, tid);
    __syncthreads();
  }
}

DEVI void attn_A(const Params& p, int layer, int it, lchar* lds) {
  const int seq = it >> 9, h = (it >> 7) & 3, qb = it & 127;
  const int tid = otid(), lane = tid & 63, wave = tid >> 6, l32 = lane & 31, g = lane >> 5;
  const int c = wave & 1, qh = wave >> 1;
  const bf16* QKV = (const bf16*)(p.ws + WS_QKV);
  bf16* O = (bf16*)(p.ws + WS_O);
  const int tokq = seq * SEQ + qb * 64 + qh * 32 + l32;
  float m = -1e30f, l = 0.f;
  f32x16 o[2];
#pragma unroll
  for (int dh = 0; dh < 2; ++dh)
#pragma unroll
    for (int r = 0; r < 16; ++r) o[dh][r] = 0.f;
  attn_full_loop<2>(QKV, seq * SEQ, tokq, 64 * h + 32 * c, 256 + 64 * h, 512 + 64 * h, 64 * c, m, l, o, lds);
  const float* lv = p.diff_lambda + layer * 128;
  float d1 = 0.f, d2 = 0.f;
#pragma unroll
  for (int i = 0; i < 32; ++i) { d1 += lv[i] * lv[32 + i]; d2 += lv[64 + i] * lv[96 + i]; }
  const float lam_init = p.lam_init[layer];
  const float lam = expf(d1) - expf(d2) + lam_init;
  const float lt = l + __shfl_xor(l, 32);
  const float sc = (c == 0) ? 1.0f / lt : lam / lt;
  LAS float* xb = (LAS float*)lds + qh * 2048;
  if (c == 1) {
#pragma unroll
    for (int dh = 0; dh < 2; ++dh)
#pragma unroll
      for (int r = 0; r < 16; ++r) xb[(dh * 16 + r) * 64 + lane] = o[dh][r] * sc;
  }
  __syncthreads();
  if (c == 0) {
    float ss = 0.f;
#pragma unroll
    for (int dh = 0; dh < 2; ++dh)
#pragma unroll
      for (int r = 0; r < 16; ++r) { const float x = o[dh][r] * sc - xb[(dh * 16 + r) * 64 + lane]; o[dh][r] = x; ss += x * x; }
    ss += __shfl_xor(ss, 32);
    const float rstd = (1.0f - lam_init) / sqrtf(ss * (1.0f / 64.0f) + EPS);
    const float* sg = p.diff_subln + layer * 64;
#pragma unroll
    for (int dh = 0; dh < 2; ++dh)
#pragma unroll
      for (int r = 0; r < 16; ++r) o[dh][r] *= sg[32 * dh + crow(r, g)];
    write_o(o, rstd, O + (size_t)tokq * DM + 64 * h, g);
  }
}

DEVI void attn_D(const Params& p, int it, lchar* lds) {
  const int seq = it >> 8, kv = (it >> 7) & 1, qb = it & 127;
  const int tid = otid(), lane = tid & 63, wave = tid >> 6, l32 = lane & 31, g = lane >> 5;
  const bf16* QKV = (const bf16*)(p.ws + WS_QKV);
  bf16* O = (bf16*)(p.ws + WS_O);
  const int hq = 2 * kv + (wave & 1);
  const int tokq = seq * SEQ + qb * 64 + (wave >> 1) * 32 + l32;
  float m = -1e30f, l = 0.f;
  f32x16 o[2];
#pragma unroll
  for (int dh = 0; dh < 2; ++dh)
#pragma unroll
    for (int r = 0; r < 16; ++r) o[dh][r] = 0.f;
  attn_full_loop<4>(QKV, seq * SEQ, tokq, 2304 + 64 * hq, 2560 + 64 * kv, 2688 + 64 * kv, 0, m, l, o, lds);
  const float lt = l + __shfl_xor(l, 32);
  write_o(o, 1.0f / lt, O + (size_t)tokq * DM + 768 + 64 * hq, g);
}

DEVI void attn_B(const Params& p, int layer, int it, lchar* lds) {
  const int seq = it >> 9, r = (it >> 2) & 127, h = it & 3;
  const int tid = otid(), lane = tid & 63, wave = tid >> 6, l32 = lane & 31, g = lane >> 5;
  const bf16* QKV = (const bf16*)(p.ws + WS_QKV);
  bf16* O = (bf16*)(p.ws + WS_O);
  const int qc = (wave & 1) * 32 + l32;
  const int tokq = seq * SEQ + r * 64 + qc;
  bf16x8 qf[4];
#pragma unroll
  for (int ks = 0; ks < 4; ++ks) qf[ks] = *(const bf16x8*)(QKV + (size_t)tokq * NQKV + 768 + 64 * h + 16 * ks + 8 * g);
  const bf16* Kp = QKV + 1024 + 64 * h;
  const bf16* Vp = QKV + 1280 + 64 * h;
  int rs = r - 4; rs = rs < 0 ? 0 : (rs > 120 ? 120 : rs);
  const int tokk = seq * SEQ + rs * 64;
  LAS float* bias = (LAS float*)(lds + AT_BIAS);
  const float* rpb = p.na_rpb + (size_t)(layer * 4 + h) * 465;
  float m = -1e30f, l = 0.f;
  f32x16 o[2];
#pragma unroll
  for (int dh = 0; dh < 2; ++dh)
#pragma unroll
    for (int rr = 0; rr < 16; ++rr) o[dh][rr] = 0.f;
  int cs = qc - 8; cs = cs < 0 ? 0 : (cs > 48 ? 48 : cs);
  KVRegs kr;
  __syncthreads();
  for (int i = tid; i < 465; i += 256) bias[i] = rpb[i] * LOG2E;
  kv_load(kr, Kp, Vp, tokk, tid);
  kv_store(kr, lds, tid);
  __syncthreads();
  for (int t = 0; t < 8; ++t) {
    lchar* buf = lds + (t & 1) * AT_BUF;
    if (t + 1 < 8) kv_load(kr, Kp, Vp, tokk + (t + 1) * 64, tid);
    if (wave < 2) {
      const int dr = rs + t - r + 7;
      f32x16 s[2];
#pragma unroll
      for (int kh = 0; kh < 2; ++kh) {
#pragma unroll
        for (int rr = 0; rr < 16; ++rr) s[kh][rr] = 0.f;
#pragma unroll
        for (int ks = 0; ks < 4; ++ks) {
          const bf16x8 a = *(const LAS bf16x8*)(buf + (kh * 32 + l32) * 144 + ks * 32 + g * 16);
          s[kh] = mfma(a, qf[ks], s[kh]);
        }
#pragma unroll
        for (int rr = 0; rr < 16; ++rr) {
          const int kc = kh * 32 + crow(rr, g);
          int dc = kc - qc + 15; dc = dc < 0 ? 0 : (dc > 30 ? 30 : dc);
          const bool valid = (kc >= cs) && (kc < cs + 16);
          s[kh][rr] = valid ? s[kh][rr] + bias[dr * 31 + dc] : -INFINITY;
        }
      }
      flash_update<2>(s, m, l, o, buf + AT_V, 4096, lane);
    }
    if (t + 1 < 8) kv_store(kr, lds + ((t + 1) & 1) * AT_BUF, tid);
    __syncthreads();
  }
  if (wave < 2) {
    const float lt = l + __shfl_xor(l, 32);
    write_o(o, 1.0f / lt, O + (size_t)tokq * DM + 256 + 64 * h, g);
  }
}

constexpr int CW_BUF = 8704, CW_V = 4608;
struct CRegs { u32x4 k[4], v[4]; };
DEVI void c_tile_params(int tg, int& st, int& j0) {
  if (tg < 5) { st = 16; j0 = -64 + 32 * tg; }
  else if (tg < 13) { st = 4; j0 = -64 + 32 * (tg - 5); }
  else { st = 1; j0 = -64 + 32 * (tg - 13); }
}
DEVI void c_load(CRegs& r, const bf16* __restrict__ Kp, const bf16* __restrict__ Vp, int seqbase, int qp0, int tg, int lane) {
  int st, j0; c_tile_params(tg, st, j0);
#pragma unroll
  for (int i = 0; i < 4; ++i) {
    const int c = lane + 64 * i, row = c >> 3, ch = c & 7;
    int kp = qp0 + st * (j0 + row); kp = kp < 0 ? 0 : (kp > SEQ - 1 ? SEQ - 1 : kp);
    r.k[i] = *(const u32x4*)(Kp + (size_t)(seqbase + kp) * NQKV + ch * 8);
    r.v[i] = *(const u32x4*)(Vp + (size_t)(seqbase + kp) * NQKV + ch * 8);
  }
}
DEVI void c_store(const CRegs& r, lchar* wb, int lane) {
#pragma unroll
  for (int i = 0; i < 4; ++i) {
    const int c = lane + 64 * i, row = c >> 3, ch = c & 7;
    *(LAS u32x4*)(wb + row * 144 + ch * 16) = r.k[i];
    *(LAS u32x4*)(wb + CW_V + (ch >> 2) * 2048 + row * 64 + (ch & 3) * 16) = r.v[i];
  }
}
DEVI void attn_C(const Params& p, int it, lchar* lds) {
  const int seq = it >> 8, h = (it >> 6) & 3, span = (it >> 2) & 15, quad = it & 3;
  const int tid = otid(), lane = tid & 63, wave = tid >> 6, l32 = lane & 31, g = lane >> 5;
  const bf16* QKV = (const bf16*)(p.ws + WS_QKV);
  bf16* O = (bf16*)(p.ws + WS_O);
  const int rho = quad * 4 + wave, qp0 = span * 512 + rho;
  const int seqbase = seq * SEQ;
  const int tokq = seqbase + qp0 + 16 * l32;
  bf16x8 qf[4];
#pragma unroll
  for (int ks = 0; ks < 4; ++ks) qf[ks] = *(const bf16x8*)(QKV + (size_t)tokq * NQKV + 1536 + 64 * h + 16 * ks + 8 * g);
  const bf16* Kp = QKV + 1792 + 64 * h;
  const bf16* Vp = QKV + 2048 + 64 * h;
  lchar* wb = lds + wave * CW_BUF;
  float m = -1e30f, l = 0.f;
  f32x16 o[2];
#pragma unroll
  for (int dh = 0; dh < 2; ++dh)
#pragma unroll
    for (int rr = 0; rr < 16; ++rr) o[dh][rr] = 0.f;
  CRegs cr;
  c_load(cr, Kp, Vp, seqbase, qp0, 0, lane);
  for (int tg = 0; tg < 33; ++tg) {
    __syncthreads();
    c_store(cr, wb, lane);
    __syncthreads();
    if (tg + 1 < 33) c_load(cr, Kp, Vp, seqbase, qp0, tg + 1, lane);
    int st, j0; c_tile_params(tg, st, j0);
    f32x16 s[1];
#pragma unroll
    for (int rr = 0; rr < 16; ++rr) s[0][rr] = 0.f;
#pragma unroll
    for (int ks = 0; ks < 4; ++ks) {
      const bf16x8 a = *(const LAS bf16x8*)(wb + l32 * 144 + ks * 32 + g * 16);
      s[0] = mfma(a, qf[ks], s[0]);
    }
#pragma unroll
    for (int rr = 0; rr < 16; ++rr) {
      const int jj = j0 + crow(rr, g);
      const int kp = qp0 + st * jj;
      int dd = 16 * l32 - st * jj; dd = dd < 0 ? -dd : dd;
      const bool valid = (dd <= 64 * st) && (kp >= 0) && (kp < SEQ);
      s[0][rr] = valid ? s[0][rr] : -INFINITY;
    }
    flash_update<1>(s, m, l, o, wb + CW_V, 2048, lane);
  }
  const float lt = l + __shfl_xor(l, 32);
  write_o(o, 1.0f / lt, O + (size_t)tokq * DM + 512 + 64 * h, g);
}

DEVI void phase_attn(const Params& p, int layer, lchar* lds) {
  constexpr int NA = NSEQ * 4 * 128, ND = NSEQ * 2 * 128, NB = NSEQ * 128 * 4, NC = NSEQ * 4 * 16 * 4;
  for (int it = blockIdx.x; it < NA + ND + NB + NC; it += gridDim.x) {
    if (it < NA) attn_A(p, layer, it, lds);
    else if (it < NA + ND) attn_D(p, it - NA, lds);
    else if (it < NA + ND + NB) attn_B(p, layer, it - NA - ND, lds);
    else attn_C(p, it - NA - ND - NB, lds);
    __syncthreads();
  }
}

DEVI void phase_merge(const Params& p, int layer, lchar* lds) {
  const bf16* H = (const bf16*)(p.ws + WS_H);
  const bf16* Ob = (const bf16*)(p.ws + WS_O);
  const bf16* Wt = (const bf16*)(p.ws + WS_WIN) + (size_t)layer * INC * DM;
  const bf16* Wb = (const bf16*)(p.ws + WS_WB) + (size_t)layer * 4 * DM * 256;
  bf16* MG = (bf16*)(p.ws + WS_QKV);
  constexpr int NT = 16, TILES = (MTOK / 128) * NT;
  for (int tile = blockIdx.x; tile < TILES; tile += gridDim.x) {
    const int tid = otid();
    const int mt = tile / NT, nt = tile - mt * NT, m0 = mt * 128, n0 = nt * 64;
    f32x16 mg[2][1]; zero_acc<1>(mg);
    for (int b = 0; b < 4; ++b) {
      f32x16 acc[2][1]; zero_acc<1>(acc);
      const int gr = NQKV + b * DM + n0;
      gemm_mainloop<1>(acc, lds, H, DM, m0, 0, MTOK - 1, Wt, DM, gr, gr, DM);
      unsigned sg[2][8];
#pragma unroll
      for (int mi = 0; mi < 2; ++mi)
#pragma unroll
        for (int i = 0; i < 8; ++i) {
          const float s0 = __builtin_amdgcn_rcpf(1.0f + ex2(-acc[mi][0][2 * i] * LOG2E));
          const float s1 = __builtin_amdgcn_rcpf(1.0f + ex2(-acc[mi][0][2 * i + 1] * LOG2E));
          sg[mi][i] = cvtpk(s0, s1);
        }
      zero_acc<1>(acc);
      gemm_mainloop<1>(acc, lds, Ob + 256 * b, DM, m0, 0, MTOK - 1, Wb + (size_t)b * DM * 256, 256, n0, n0, 256);
#pragma unroll
      for (int mi = 0; mi < 2; ++mi)
#pragma unroll
        for (int i = 0; i < 8; ++i) {
          const unsigned w = sg[mi][i];
          mg[mi][0][2 * i] += __uint_as_float(w << 16) * acc[mi][0][2 * i];
          mg[mi][0][2 * i + 1] += __uint_as_float(w & 0xffff0000u) * acc[mi][0][2 * i + 1];
        }
    }
    acc_to_lds<1>(mg, lds);
    __syncthreads();
    {
      const LAS float* Cs = (const LAS float*)lds;
#pragma unroll
      for (int i = 0; i < 4; ++i) {
        const int id = tid + 256 * i, row = id >> 3, ch = id & 7;
        const f32x4 a = *(const LAS f32x4*)(Cs + row * CP + ch * 8), b2 = *(const LAS f32x4*)(Cs + row * CP + ch * 8 + 4);
        u32x4 o; o.x = cvtpk(a.x, a.y); o.y = cvtpk(a.z, a.w); o.z = cvtpk(b2.x, b2.y); o.w = cvtpk(b2.z, b2.w);
        *(u32x4*)(MG + (size_t)(m0 + row) * DM + n0 + ch * 8) = o;
      }
    }
    __syncthreads();
  }
}

DEVI void phase_resid(const Params& p, const bf16* A, int lda, const bf16* Wt, int K, lchar* lds) {
  const int tid = otid();
  constexpr int NT = 8, TILES = (MTOK / 128) * NT;
  for (int tile = blockIdx.x; tile < TILES; tile += gridDim.x) {
    const int mt = tile / NT, nt = tile - mt * NT, m0 = mt * 128, n0 = nt * 128;
    f32x16 acc[2][2]; zero_acc<2>(acc);
    gemm_mainloop<2>(acc, lds, A, lda, m0, 0, MTOK - 1, Wt, K, n0, n0 + 64, K);
    acc_to_lds<2>(acc, lds);
    __syncthreads();
    {
      const LAS float* Cs = (const LAS float*)lds;
#pragma unroll
      for (int i = 0; i < 16; ++i) {
        const int id = tid + 256 * i, row = id >> 5, c4 = id & 31;
        const f32x4 a = *(const LAS f32x4*)(Cs + row * CP + c4 * 4);
        f32x4* xp = (f32x4*)(p.out + (size_t)(m0 + row) * DM + n0 + c4 * 4);
        *xp = *xp + a;
      }
    }
    __syncthreads();
  }
}

DEVI float gelu_exact(float x) { return 0.5f * x * (1.0f + erff(x * 0.70710678118654752f)); }
DEVI void phase_up(const Params& p, int layer, lchar* lds) {
  const bf16* H = (const bf16*)(p.ws + WS_H);
  const bf16* Wt = (const bf16*)(p.ws + WS_WUP) + (size_t)layer * NUP * DM;
  bf16* ACT = (bf16*)(p.ws + WS_QKV);
  const float* cw = p.conv_w + (size_t)layer * 3 * NUP;
  const float* cb = p.conv_b + (size_t)layer * NUP;
  const int tid = otid();
  constexpr int MT = 66, NT = 44, TILES = NSEQ * MT * NT;
  for (int tile = blockIdx.x; tile < TILES; tile += gridDim.x) {
    const int sm = tile / NT, nt = tile - sm * NT, seq = sm / MT, mt = sm - seq * MT;
    const int seqbase = seq * SEQ, p0 = 126 * mt - 1;
    f32x16 acc[2][2]; zero_acc<2>(acc);
    gemm_mainloop<2>(acc, lds, H, DM, seqbase + p0, seqbase, seqbase + SEQ - 1, Wt, DM, 64 * nt, DFF + 64 * nt, DM);
    acc_to_lds<2>(acc, lds);
    __syncthreads();
    {
      const LAS float* Cs = (const LAS float*)lds;
#pragma unroll
      for (int i = 0; i < 4; ++i) {
        const int id = tid + 256 * i, lr = 1 + (id >> 3), ch = id & 7, pp = p0 + lr;
        if (lr <= 126 && pp < SEQ) {
          const int c0 = 64 * nt + ch * 8;
          const float wp = pp > 0 ? 1.f : 0.f, wn = pp < SEQ - 1 ? 1.f : 0.f;
          float res[8];
#pragma unroll
          for (int hh = 0; hh < 2; ++hh) {
            const f32x4 um = *(const LAS f32x4*)(Cs + (lr - 1) * CP + ch * 8 + 4 * hh), uc = *(const LAS f32x4*)(Cs + lr * CP + ch * 8 + 4 * hh),
                        un = *(const LAS f32x4*)(Cs + (lr + 1) * CP + ch * 8 + 4 * hh);
            const f32x4 gm = *(const LAS f32x4*)(Cs + (lr - 1) * CP + 64 + ch * 8 + 4 * hh), gc = *(const LAS f32x4*)(Cs + lr * CP + 64 + ch * 8 + 4 * hh),
                        gn = *(const LAS f32x4*)(Cs + (lr + 1) * CP + 64 + ch * 8 + 4 * hh);
            const f32x4 w0 = *(const f32x4*)(cw + c0 + 4 * hh), w1 = *(const f32x4*)(cw + NUP + c0 + 4 * hh), w2 = *(const f32x4*)(cw + 2 * NUP + c0 + 4 * hh), bb = *(const f32x4*)(cb + c0 + 4 * hh);
            const f32x4 v0 = *(const f32x4*)(cw + DFF + c0 + 4 * hh), v1 = *(const f32x4*)(cw + NUP + DFF + c0 + 4 * hh), v2 = *(const f32x4*)(cw + 2 * NUP + DFF + c0 + 4 * hh), vb = *(const f32x4*)(cb + DFF + c0 + 4 * hh);
            const f32x4 val = um * w0 * wp + uc * w1 + un * w2 * wn + bb;
            const f32x4 gt = gm * v0 * wp + gc * v1 + gn * v2 * wn + vb;
            res[4 * hh + 0] = gelu_exact(gt.x) * val.x; res[4 * hh + 1] = gelu_exact(gt.y) * val.y;
            res[4 * hh + 2] = gelu_exact(gt.z) * val.z; res[4 * hh + 3] = gelu_exact(gt.w) * val.w;
          }
          u32x4 o; o.x = cvtpk(res[0], res[1]); o.y = cvtpk(res[2], res[3]); o.z = cvtpk(res[4], res[5]); o.w = cvtpk(res[6], res[7]);
          *(u32x4*)(ACT + (size_t)(seqbase + pp) * DFF + c0) = o;
        }
      }
    }
    __syncthreads();
  }
}

constexpr int NPHASE = 17;
__global__ void __launch_bounds__(256, 2) fwd_kernel(Params p) {
  __shared__ __attribute__((aligned(16))) char lds_raw[LDS_BYTES];
  lchar* lds = (lchar*)lds_raw;
  for (int ph = p.phase_lo; ph <= p.phase_hi; ++ph) {
    if (ph > p.phase_lo) cg::this_grid().sync();
    if (ph == 0) { phase_weights(p, lds); phase_norm(p, 0, p.norm_attn); continue; }
    const int layer = (ph - 1) >> 3, sub = (ph - 1) & 7;
    switch (sub) {
      case 0: phase_qkv(p, layer, lds); break;
      case 1: phase_attn(p, layer, lds); break;
      case 2: phase_merge(p, layer, lds); break;
      case 3: phase_resid(p, (const bf16*)(p.ws + WS_QKV), DM, (const bf16*)(p.ws + WS_WOUT) + (size_t)layer * DM * DM, DM, lds); break;
      case 4: phase_norm(p, 1, p.norm_mlp + layer * DM); break;
      case 5: phase_up(p, layer, lds); break;
      case 6: phase_resid(p, (const bf16*)(p.ws + WS_QKV), DFF, (const bf16*)(p.ws + WS_WDN) + (size_t)layer * DM * DFF, DFF, lds); break;
      default: if (layer == 0) phase_norm(p, 1, p.norm_attn + DM); else phase_norm(p, 2, p.norm_final); break;
    }
  }
}

extern "C" void kernel_launch(void* const* d_in, const int* in_sizes, int n_in, void* d_out, int out_size, void* d_ws, size_t ws_size, hipStream_t stream) {
  static int grid = 0;
  if (grid == 0) {
    if (n_in != 16 || out_size != MTOK * DM || ws_size < WS_END) { fprintf(stderr, "kernel_launch: unexpected shapes (n_in %d out %d ws %zu need %zu)\n", n_in, out_size, ws_size, (size_t)WS_END); grid = -1; return; }
    int dev = 0, cus = 0, per_cu = 0;
    hipGetDevice(&dev);
    hipDeviceGetAttribute(&cus, hipDeviceAttributeMultiprocessorCount, dev);
    hipOccupancyMaxActiveBlocksPerMultiprocessor(&per_cu, fwd_kernel, 256, 0);
    if (per_cu < 1) per_cu = 1;
    if (per_cu > 2) per_cu = 2;
    grid = cus * per_cu;
  }
  if (grid < 0) return;
  Params p{};
  p.xp = (const float*)d_in[0]; p.xs = (const float*)d_in[1]; p.norm_attn = (const float*)d_in[2]; p.w_in = (const float*)d_in[3];
  p.diff_lambda = (const float*)d_in[4]; p.diff_subln = (const float*)d_in[5]; p.na_rpb = (const float*)d_in[6]; p.qk_norm = (const float*)d_in[7];
  p.w_branch = (const float*)d_in[8]; p.w_out = (const float*)d_in[9]; p.norm_mlp = (const float*)d_in[10]; p.w_up = (const float*)d_in[11];
  p.conv_w = (const float*)d_in[12]; p.conv_b = (const float*)d_in[13]; p.w_down = (const float*)d_in[14]; p.norm_final = (const float*)d_in[15];
  p.out = (float*)d_out; p.ws = (char*)d_ws;
  const double TWO_PI = 6.283185307179586476925286766559;
  for (int i = 0; i < 4; ++i) p.invA[i] = std::exp(-std::log(500000.0) * i / 4.0) / TWO_PI;
  for (int i = 0; i < 8; ++i) p.invC[i] = std::exp(-std::log(500000.0) * i / 8.0) / TWO_PI;
  for (int i = 0; i < 16; ++i) p.invD[i] = std::exp(-std::log(10000.0) * i / 16.0) / TWO_PI;
  for (int l = 0; l < 2; ++l) p.lam_init[l] = (float)(0.8 - 0.6 * std::exp(-0.3 * l));
#if MEGA
  p.phase_lo = 0; p.phase_hi = NPHASE - 1;
  void* args[] = {&p};
  hipError_t e = hipLaunchCooperativeKernel((void*)fwd_kernel, dim3(grid), dim3(256), args, 0, stream);
  if (e != hipSuccess) fprintf(stderr, "cooperative launch failed: %s (grid %d)\n", hipGetErrorString(e), grid);
#else
  for (int ph = 0; ph < NPHASE; ++ph) {
    p.phase_lo = ph; p.phase_hi = ph;
    hipLaunchKernelGGL(fwd_kernel, dim3(grid), dim3(256), 0, stream, p);
  }
#endif
}
```

```cpp
#include <hip/hip_runtime.h>
#include <hip/hip_cooperative_groups.h>
#include <cstdio>
#include <cmath>
namespace cg = cooperative_groups;

#ifndef MEGA
#define MEGA 1
#endif

#ifndef PROBE_DUP
#define PROBE_DUP 0
#endif
#define DEVI __device__ __forceinline__
#define LAS __attribute__((address_space(3)))
typedef unsigned short bf16;
typedef short bf16x8 __attribute__((ext_vector_type(8)));
typedef short s16x4 __attribute__((ext_vector_type(4)));
typedef float f32x16 __attribute__((ext_vector_type(16)));
typedef float f32x4 __attribute__((ext_vector_type(4)));
typedef float f32x2_t __attribute__((ext_vector_type(2)));
typedef __bf16 bf16x2_t __attribute__((ext_vector_type(2)));
typedef unsigned u32x4 __attribute__((ext_vector_type(4)));
typedef unsigned u32x2 __attribute__((ext_vector_type(2)));
typedef LAS char lchar;

constexpr int DM = 1024, SEQ = 8192, NSEQ = 10, MTOK = NSEQ * SEQ, NQKV = 2816, INC = 6912, DFF = 2816, NUP = 5632;
constexpr float LOG2E = 1.4426950408889634f;
constexpr float EPS = 1e-6f;
constexpr int NTHR = 512;
constexpr int LDS_BYTES = 147456;
constexpr int CP = 260;

constexpr size_t SZ_WIN = (size_t)2 * INC * DM * 2, SZ_WB = (size_t)2 * 4 * DM * 256 * 2, SZ_WOUT = (size_t)2 * DM * DM * 2,
                 SZ_WUP = (size_t)2 * NUP * DM * 2, SZ_WDN = (size_t)2 * DM * DFF * 2;
constexpr size_t WS_WIN = 0, WS_WB = WS_WIN + SZ_WIN, WS_WOUT = WS_WB + SZ_WB, WS_WUP = WS_WOUT + SZ_WOUT, WS_WDN = WS_WUP + SZ_WUP;
constexpr size_t WS_H = WS_WDN + SZ_WDN;
constexpr size_t WS_O = WS_H + (size_t)MTOK * DM * 2;
constexpr size_t WS_QKV = WS_O + (size_t)MTOK * DM * 2;
constexpr size_t WS_CTL = WS_QKV + (size_t)MTOK * NQKV * 2;
constexpr size_t CTL_BYTES = 16384;
constexpr size_t WS_PART = WS_CTL + CTL_BYTES;
constexpr size_t WS_END = WS_PART + (size_t)4 * MTOK * 4;

struct Params {
  const float *xp, *xs, *norm_attn, *w_in, *diff_lambda, *diff_subln, *na_rpb, *qk_norm, *w_branch, *w_out, *norm_mlp, *w_up, *conv_w, *conv_b, *w_down, *norm_final;
  float* out; char* ws;
  double invA[4], invC[8], invD[16];
  float lam_init[2]; int nseq, pad0;
  unsigned long long seq0, seq1;
};

DEVI unsigned cvtpk(float lo, float hi) { f32x2_t v = {lo, hi}; bf16x2_t b = __builtin_convertvector(v, bf16x2_t); return __builtin_bit_cast(unsigned, b); }
DEVI float bf2f(unsigned short h) { return __uint_as_float(((unsigned)h) << 16); }
DEVI f32x16 mfma(bf16x8 a, bf16x8 b, f32x16 c) { return __builtin_amdgcn_mfma_f32_32x32x16_bf16(a, b, c, 0, 0, 0); }
DEVI int crow(int r, int g) { return (r & 3) + 8 * (r >> 2) + 4 * g; }
DEVI float ex2(float x) { return __builtin_amdgcn_exp2f(x); }
DEVI s16x4 trread(const lchar* p) { return __builtin_bit_cast(s16x4, __builtin_amdgcn_ds_read_tr16_b64_v4i16((LAS s16x4*)p)); }
DEVI int otid() { int t = threadIdx.x; asm volatile("" : "+v"(t)); return t; }
DEVI float wave_sum(float v) {
#pragma unroll
  for (int o = 1; o < 64; o <<= 1) v += __shfl_xor(v, o);
  return v;
}

#define WAITBAR(N) asm volatile("s_waitcnt vmcnt(" #N ") lgkmcnt(0)\n\ts_barrier" ::: "memory")
template <int MI, bool CHAIN = false>
DEVI void gemm_dma(f32x16 (&acc)[MI][2], lchar* lds, const bf16* __restrict__ A, int lda, int arow0, int alo, int ahi,
                   const bf16* __restrict__ B, int ldb, int brow0, int brow1, int K,
                   bool has_prev = false, const bf16* __restrict__ nA = nullptr, int nlda = 0, const bf16* __restrict__ nB = nullptr, int nldb = 0, int nbrow0 = 0, int nbrow1 = 0) {
  constexpr int ABYTES = 64 * MI * 64, STAGE = ABYTES + 16384, NAI = MI / 2;
  const int tid = otid(), lane = tid & 63, wave = __builtin_amdgcn_readfirstlane(tid >> 6), wr = wave >> 2, wc = wave & 3, l32 = lane & 31, g = lane >> 5;
  int offA[NAI], offB[2];
#pragma unroll
  for (int i = 0; i < NAI; ++i) {
    const int r = wave * 8 * MI + 16 * i + (lane >> 2), c = (lane & 3) ^ ((r >> 2) & 3);
    int ar = arow0 + r; ar = ar < alo ? alo : (ar > ahi ? ahi : ar);
    offA[i] = ar * lda + c * 8;
  }
#pragma unroll
  for (int i = 0; i < 2; ++i) {
    const int r = wave * 32 + 16 * i + (lane >> 2), c = (lane & 3) ^ ((r >> 2) & 3);
    const int br = (r < 128) ? brow0 + r : brow1 + r - 128;
    offB[i] = br * ldb + c * 8;
  }
  const bool has_next = CHAIN && (nA != nullptr);
  int noffA[NAI], noffB[2];
  if (CHAIN) {
#pragma unroll
    for (int i = 0; i < NAI; ++i) {
      const int r = wave * 8 * MI + 16 * i + (lane >> 2), c = (lane & 3) ^ ((r >> 2) & 3);
      int ar = arow0 + r; ar = ar < alo ? alo : (ar > ahi ? ahi : ar);
      noffA[i] = ar * nlda + c * 8;
    }
#pragma unroll
    for (int i = 0; i < 2; ++i) {
      const int r = wave * 32 + 16 * i + (lane >> 2), c = (lane & 3) ^ ((r >> 2) & 3);
      const int br = (r < 128) ? nbrow0 + r : nbrow1 + r - 128;
      noffB[i] = br * nldb + c * 8;
    }
  }
  const int ldA = wave * 8 * MI * 64, ldB = ABYTES + wave * 32 * 64;
#define DMA_NEXT(kt, sofs) do { \
    _Pragma("unroll") for (int i_ = 0; i_ < NAI; ++i_) __builtin_amdgcn_global_load_lds((const unsigned*)(nA + noffA[i_] + (kt) * 32), (LAS unsigned*)(lds + (sofs) + ldA + i_ * 1024), 16, 0, 0); \
    _Pragma("unroll") for (int i_ = 0; i_ < 2; ++i_) __builtin_amdgcn_global_load_lds((const unsigned*)(nB + noffB[i_] + (kt) * 32), (LAS unsigned*)(lds + (sofs) + ldB + i_ * 1024), 16, 0, 0); } while (0)
#define DMA_TILE(kt, sofs) do { \
    _Pragma("unroll") for (int i_ = 0; i_ < NAI; ++i_) __builtin_amdgcn_global_load_lds((const unsigned*)(A + offA[i_] + (kt) * 32), (LAS unsigned*)(lds + (sofs) + ldA + i_ * 1024), 16, 0, 0); \
    _Pragma("unroll") for (int i_ = 0; i_ < 2; ++i_) __builtin_amdgcn_global_load_lds((const unsigned*)(B + offB[i_] + (kt) * 32), (LAS unsigned*)(lds + (sofs) + ldB + i_ * 1024), 16, 0, 0); } while (0)
  const int nk = K >> 5;
  if (!(CHAIN && has_prev)) {
    DMA_TILE(0, 0);
    DMA_TILE(1, STAGE);
    DMA_TILE(2, 2 * STAGE);
    if constexpr (MI == 4) WAITBAR(8); else WAITBAR(6);
  }
  const unsigned ldsbase = (unsigned)(size_t)lds;
  const int swz = (l32 >> 2) & 3;
  const int arow = (wr * 32 * MI + l32) * 64, brow = ABYTES + (wc * 64 + l32) * 64;
  const int ck0 = (g ^ swz) * 16, ck1 = ((2 + g) ^ swz) * 16;
#define FRAG_READ(AF, BF, aaddr, baddr) do { \
    _Pragma("unroll") for (int ni_ = 0; ni_ < 2; ++ni_) asm volatile("ds_read_b128 %0, %1 offset:%2" : "=&v"(BF[ni_]) : "v"(baddr), "n"(ni_ * 2048) : "memory"); \
    _Pragma("unroll") for (int mi_ = 0; mi_ < MI; ++mi_) asm volatile("ds_read_b128 %0, %1 offset:%2" : "=&v"(AF[mi_]) : "v"(aaddr), "n"(mi_ * 2048) : "memory"); } while (0)
#define PLAINBAR() asm volatile("s_barrier" ::: "memory")
  bf16x8 af0[MI], bf0[2], af1[MI], bf1[2];
  if (wr == 1) PLAINBAR();
  int cur = 0;
  for (int t = 0; t < nk; ++t) {
    FRAG_READ(af0, bf0, ldsbase + (unsigned)(cur + arow + ck0), ldsbase + (unsigned)(cur + brow + ck0));
    FRAG_READ(af1, bf1, ldsbase + (unsigned)(cur + arow + ck1), ldsbase + (unsigned)(cur + brow + ck1));
    if (t + 2 < nk || has_next) { if constexpr (MI == 4) WAITBAR(4); else WAITBAR(3); }
    else WAITBAR(0);
    int nx = cur + 3 * STAGE; if (nx >= 4 * STAGE) nx -= 4 * STAGE;
    __builtin_amdgcn_sched_barrier(0);
#pragma unroll
    for (int mi = 0; mi < MI; ++mi)
#pragma unroll
      for (int ni = 0; ni < 2; ++ni) acc[mi][ni] = mfma(af0[mi], bf0[ni], acc[mi][ni]);
    __builtin_amdgcn_sched_barrier(0);
    if (t + 3 < nk) DMA_TILE(t + 3, nx);
    else if (has_next) DMA_NEXT(t + 3 - nk, nx);
    __builtin_amdgcn_sched_barrier(0);
#pragma unroll
    for (int mi = 0; mi < MI; ++mi)
#pragma unroll
      for (int ni = 0; ni < 2; ++ni) acc[mi][ni] = mfma(af1[mi], bf1[ni], acc[mi][ni]);
    __builtin_amdgcn_sched_barrier(0);
    PLAINBAR();
    cur += STAGE; if (cur >= 4 * STAGE) cur -= 4 * STAGE;
  }
  if (wr == 0) PLAINBAR();
#undef FRAG_READ
#undef PLAINBAR
#undef DMA_TILE
#undef DMA_NEXT
}

template <int MI>
DEVI void zero_acc(f32x16 (&acc)[MI][2]) {
#pragma unroll
  for (int a = 0; a < MI; ++a)
#pragma unroll
    for (int b = 0; b < 2; ++b)
#pragma unroll
      for (int r = 0; r < 16; ++r) acc[a][b][r] = 0.f;
}

DEVI void acc_to_lds(const f32x16 (&acc)[2][2], lchar* lds) {
  const int tid = otid(), lane = tid & 63, wave = tid >> 6, wr = wave >> 2, wc = wave & 3, l32 = lane & 31, g = lane >> 5;
  LAS float* Cs = (LAS float*)lds;
#pragma unroll
  for (int mi = 0; mi < 2; ++mi)
#pragma unroll
    for (int ni = 0; ni < 2; ++ni)
#pragma unroll
      for (int r = 0; r < 16; ++r) Cs[(wr * 64 + mi * 32 + crow(r, g)) * CP + wc * 64 + ni * 32 + l32] = acc[mi][ni][r];
}
DEVI void acc_to_lds_half(const f32x16 (&acc)[4][2], lchar* lds, int hf, int rowofs) {
  const int tid = otid(), lane = tid & 63, wave = __builtin_amdgcn_readfirstlane(tid >> 6), wr = wave >> 2, wc = wave & 3, l32 = lane & 31, g = lane >> 5;
  LAS float* Cs = (LAS float*)lds;
  if (wr == hf) {
#pragma unroll
    for (int mi = 0; mi < 4; ++mi)
#pragma unroll
      for (int ni = 0; ni < 2; ++ni)
#pragma unroll
        for (int r = 0; r < 16; ++r) Cs[(rowofs + mi * 32 + crow(r, g)) * CP + wc * 64 + ni * 32 + l32] = acc[mi][ni][r];
  }
}

DEVI int xsched_idx(int i) { const int ns = gridDim.x >> 3; return (i * 8 + (int)(blockIdx.x & 7)) * ns + (int)(blockIdx.x >> 3); }
DEVI bool gemm_tile(int idx, int MT, int NT, int& mt, int& nt) { const int mg = idx / (4 * NT), rem = idx - mg * 4 * NT; nt = rem >> 2; mt = mg * 4 + (rem & 3); return mt < MT; }

DEVI void transpose_item(const float* __restrict__ W, int K, int N, bf16* __restrict__ Wt, int item, lchar* lds, const float* __restrict__ gain = nullptr) {
  const int nnb = N >> 6, kb = item / nnb, nb = item - kb * nnb, tid = otid();
  LAS float* t = (LAS float*)lds;
  __syncthreads();
#pragma unroll
  for (int i = 0; i < 8; ++i) { const int k = (tid >> 6) + 8 * i, n = tid & 63; t[k * 65 + n] = W[(size_t)(kb * 64 + k) * N + nb * 64 + n] * (gain ? gain[kb * 64 + k] : 1.0f); }
  __syncthreads();
  {
    const int n = tid >> 3, kc = tid & 7;
    float v[8];
#pragma unroll
    for (int j = 0; j < 8; ++j) v[j] = t[(kc * 8 + j) * 65 + n];
    u32x4 o; o.x = cvtpk(v[0], v[1]); o.y = cvtpk(v[2], v[3]); o.z = cvtpk(v[4], v[5]); o.w = cvtpk(v[6], v[7]);
    *(u32x4*)(Wt + (size_t)(nb * 64 + n) * K + kb * 64 + kc * 8) = o;
  }
}

DEVI void phase_weights(const Params& p, lchar* lds) {
  constexpr int I_IN = 16 * 108, I_B = 4 * 16, I_OUT = 16 * 16, I_UP = 16 * 88, I_DN = 44 * 16;
  constexpr int T_IN = 2 * I_IN, T_B = 8 * I_B, T_OUT = 2 * I_OUT, T_UP = 2 * I_UP, T_DN = 2 * I_DN;
  constexpr int TOTAL = T_IN + T_B + T_OUT + T_UP + T_DN;
  for (int it = blockIdx.x; it < TOTAL; it += gridDim.x) {
    int r = it;
    if (r < T_IN) { const int l = r / I_IN; transpose_item(p.w_in + (size_t)l * DM * INC, DM, INC, (bf16*)(p.ws + WS_WIN) + (size_t)l * INC * DM, r - l * I_IN, lds); continue; }
    r -= T_IN;
    if (r < T_B) { const int lb = r / I_B; transpose_item(p.w_branch + (size_t)lb * 256 * DM, 256, DM, (bf16*)(p.ws + WS_WB) + (size_t)lb * DM * 256, r - lb * I_B, lds); continue; }
    r -= T_B;
    if (r < T_OUT) { const int l = r / I_OUT; transpose_item(p.w_out + (size_t)l * DM * DM, DM, DM, (bf16*)(p.ws + WS_WOUT) + (size_t)l * DM * DM, r - l * I_OUT, lds); continue; }
    r -= T_OUT;
    if (r < T_UP) { const int l = r / I_UP; transpose_item(p.w_up + (size_t)l * DM * NUP, DM, NUP, (bf16*)(p.ws + WS_WUP) + (size_t)l * NUP * DM, r - l * I_UP, lds, p.norm_mlp + l * DM); continue; }
    r -= T_UP;
    { const int l = r / I_DN; transpose_item(p.w_down + (size_t)l * DFF * DM, DFF, DM, (bf16*)(p.ws + WS_WDN) + (size_t)l * DM * DFF, r - l * I_DN, lds); }
  }
}

DEVI void phase_norm(const Params& p, int mode, const float* __restrict__ gain) {
  const int lane = otid() & 63, gw = blockIdx.x * 8 + (otid() >> 6), ngw = gridDim.x * 8;
  bf16* H = (bf16*)(p.ws + WS_H);
  f32x4 gg[4];
#pragma unroll
  for (int j = 0; j < 4; ++j) gg[j] = ((const f32x4*)gain)[lane + 64 * j];
  for (int row0 = gw; row0 < MTOK / 2; row0 += ngw) {
    f32x4 v[2][4]; float ss[2];
#pragma unroll
    for (int u = 0; u < 2; ++u) {
      const int row = row0 + u * (MTOK / 2);
      const float* src = (mode == 0) ? (row < 2 * SEQ ? p.xp + (size_t)row * DM : p.xs + (size_t)(row - 2 * SEQ) * DM) : p.out + (size_t)row * DM;
#pragma unroll
      for (int j = 0; j < 4; ++j) v[u][j] = ((const f32x4*)src)[lane + 64 * j];
    }
#pragma unroll
    for (int u = 0; u < 2; ++u) {
      float s = 0.f;
#pragma unroll
      for (int j = 0; j < 4; ++j) s += (v[u][j].x * v[u][j].x + v[u][j].y * v[u][j].y) + (v[u][j].z * v[u][j].z + v[u][j].w * v[u][j].w);
      ss[u] = wave_sum(s);
    }
#pragma unroll
    for (int u = 0; u < 2; ++u) {
      const int row = row0 + u * (MTOK / 2);
      const float rstd = 1.0f / sqrtf(ss[u] * (1.0f / DM) + EPS);
      float* orow = p.out + (size_t)row * DM;
#pragma unroll
      for (int j = 0; j < 4; ++j) {
        if (mode == 0) ((f32x4*)orow)[lane + 64 * j] = v[u][j];
        const f32x4 y = v[u][j] * rstd * gg[j];
        if (mode == 2) ((f32x4*)orow)[lane + 64 * j] = y;
        else { u32x2 w; w.x = cvtpk(y.x, y.y); w.y = cvtpk(y.z, y.w); ((u32x2*)(H + (size_t)row * DM))[lane + 64 * j] = w; }
      }
    }
  }
}

DEVI float row_rstd(const Params& p, int row) {
  const float* P = (const float*)(p.ws + WS_PART);
  const float s = (P[row] + P[(size_t)MTOK + row]) + (P[(size_t)2 * MTOK + row] + P[(size_t)3 * MTOK + row]);
  return 1.0f / sqrtf(s * (1.0f / DM) + EPS);
}
constexpr int RS_OFF4 = 139264, RS_OFF2 = 98304;

DEVI void rot(float& a, float& b, double t) {
  const float rv = (float)(t - __builtin_rint(t));
  const float cs = __builtin_amdgcn_cosf(rv), sn = __builtin_amdgcn_sinf(rv);
  const float x1 = a, x2 = b; a = x1 * cs - x2 * sn; b = x2 * cs + x1 * sn;
}

DEVI void phase_qkv(const Params& p, int layer, lchar* lds) {
  const bf16* H = (const bf16*)(p.ws + WS_H);
  const bf16* Wt = (const bf16*)(p.ws + WS_WIN) + (size_t)layer * INC * DM;
  bf16* QKV = (bf16*)(p.ws + WS_QKV);
  const int tid = otid();
  constexpr int NT = 11, MT = MTOK / 256, TILES = MT * NT;
  for (int i = 0;; ++i) {
    const int idx = xsched_idx(i); if (idx >= TILES) break;
    int mt, nt; gemm_tile(idx, MT, NT, mt, nt);
    const int n0 = nt * 256;
    f32x16 acc[4][2]; zero_acc<4>(acc);
    gemm_dma<4>(acc, lds, H, DM, mt * 256, 0, MTOK - 1, Wt, DM, n0, n0 + 128, DM);
    {
      const int lane = tid & 63, wave = __builtin_amdgcn_readfirstlane(tid >> 6), wr = wave >> 2, wc = wave & 3, l32 = lane & 31, g = lane >> 5;
      LAS float* Wp = (LAS float*)(lds + wave * 17408);
      const int G = nt * 4 + wc;
      const float qs = 0.125f * LOG2E;
      const bool isD = (G >= 36 && G < 42);
#pragma unroll
      for (int c2 = 0; c2 < 2; ++c2) {
#pragma unroll
        for (int mi = 0; mi < 2; ++mi)
#pragma unroll
          for (int ni = 0; ni < 2; ++ni)
#pragma unroll
            for (int r = 0; r < 16; ++r) Wp[(mi * 32 + crow(r, g)) * 68 + ni * 32 + l32] = acc[2 * c2 + mi][ni][r];
        asm volatile("s_waitcnt lgkmcnt(0)" ::: "memory");
        const int grow = mt * 256 + wr * 128 + c2 * 64 + lane, pos = grow & (SEQ - 1);
        const LAS float* rowp = Wp + lane * 68;
        float rstd = 1.f;
        if (isD) {
          float ss = 0.f;
#pragma unroll
          for (int i = 0; i < 16; ++i) { const f32x4 t = *(const LAS f32x4*)(rowp + 4 * i); ss += (t.x * t.x + t.y * t.y) + (t.z * t.z + t.w * t.w); }
          rstd = 1.0f / sqrtf(ss * (1.0f / 64.0f) + EPS);
        }
        bf16* dst = QKV + (size_t)grow * NQKV + G * 64;
#pragma unroll 1
        for (int hh = 0; hh < 2; ++hh) {
          float v[32];
#pragma unroll
          for (int i = 0; i < 8; ++i) { const f32x4 t = *(const LAS f32x4*)(rowp + hh * 32 + 4 * i); v[4 * i] = t.x; v[4 * i + 1] = t.y; v[4 * i + 2] = t.z; v[4 * i + 3] = t.w; }
          float sc = 1.f;
          if (G < 8) {
#pragma unroll
            for (int i = 0; i < 4; ++i) rot(v[i], v[4 + i], (double)pos * p.invA[i]);
            if (G < 4) sc = 0.17677669529663687f * LOG2E;
          } else if (G >= 12 && G < 16) { sc = qs;
          } else if (G >= 24 && G < 32) {
            if (hh == 0) {
#pragma unroll
              for (int i = 0; i < 8; ++i) rot(v[i], v[8 + i], (double)pos * p.invC[i]);
            }
            if (G < 28) sc = qs;
          } else if (isD) {
            const float* gq = p.qk_norm + layer * 128 + (G < 40 ? 0 : 64) + hh * 32;
#pragma unroll
            for (int i = 0; i < 32; ++i) v[i] = v[i] * rstd * gq[i];
            const int pa = hh == 0 ? (pos >> 6) : (pos & 63);
#pragma unroll
            for (int i = 0; i < 16; ++i) rot(v[i], v[16 + i], (double)pa * p.invD[i]);
            if (G < 40) sc = qs;
          }
#pragma unroll
          for (int i = 0; i < 4; ++i) {
            u32x4 o; o.x = cvtpk(v[8 * i] * sc, v[8 * i + 1] * sc); o.y = cvtpk(v[8 * i + 2] * sc, v[8 * i + 3] * sc);
            o.z = cvtpk(v[8 * i + 4] * sc, v[8 * i + 5] * sc); o.w = cvtpk(v[8 * i + 6] * sc, v[8 * i + 7] * sc);
            ((u32x4*)(dst + hh * 32))[i] = o;
          }
        }
        asm volatile("s_waitcnt lgkmcnt(0)" ::: "memory");
      }
    }
    __syncthreads();
  }
}

struct FState { float m; bool init; f32x16 negm; f32x16 o[2]; f32x16 ls; };
DEVI void fstate_init(FState& st) {
  st.m = 0.f; st.init = false;
#pragma unroll
  for (int r = 0; r < 16; ++r) { st.negm[r] = 0.f; st.o[0][r] = 0.f; st.o[1][r] = 0.f; st.ls[r] = 0.f; }
}
template <int NKH>
DEVI void flash_update(f32x16 (&s)[NKH], FState& st, const lchar* vb, int dhs, int lane) {
  float mx = s[0][0];
#pragma unroll
  for (int kh = 0; kh < NKH; ++kh)
#pragma unroll
    for (int r = 0; r < 16; ++r) mx = fmaxf(mx, s[kh][r]);
  mx = fmaxf(mx, __shfl_xor(mx, 32));
  const bool fin = mx > -1e30f;
  const bool upd = (mx > 8.0f) || (!st.init && fin);
  st.init = st.init || fin;
  if (__any(upd)) {
    const float d = upd ? mx : 0.f;
    st.m += d;
    const float alpha = ex2(-d);
#pragma unroll
    for (int dh = 0; dh < 2; ++dh)
#pragma unroll
      for (int r = 0; r < 16; ++r) st.o[dh][r] *= alpha;
#pragma unroll
    for (int r = 0; r < 16; ++r) st.ls[r] *= alpha;
#pragma unroll
    for (int kh = 0; kh < NKH; ++kh)
#pragma unroll
      for (int r = 0; r < 16; ++r) s[kh][r] -= d;
    const float nm = -st.m;
#pragma unroll
    for (int r = 0; r < 16; ++r) st.negm[r] = nm;
  }
#pragma unroll
  for (int kh = 0; kh < NKH; ++kh)
#pragma unroll
    for (int r = 0; r < 16; ++r) s[kh][r] = ex2(s[kh][r]);
  const int g = lane >> 5;
  const lchar* vp = vb + (4 * g + ((lane & 15) >> 2)) * 64 + ((lane >> 4) & 1) * 32 + (lane & 3) * 8;
  const bf16x8 ones = {0x3f80, 0x3f80, 0x3f80, 0x3f80, 0x3f80, 0x3f80, 0x3f80, 0x3f80};
#pragma unroll
  for (int kh = 0; kh < NKH; ++kh)
#pragma unroll
    for (int j = 0; j < 2; ++j) {
      u32x4 pw; pw.x = cvtpk(s[kh][8 * j], s[kh][8 * j + 1]); pw.y = cvtpk(s[kh][8 * j + 2], s[kh][8 * j + 3]);
      pw.z = cvtpk(s[kh][8 * j + 4], s[kh][8 * j + 5]); pw.w = cvtpk(s[kh][8 * j + 6], s[kh][8 * j + 7]);
      const bf16x8 pb = __builtin_bit_cast(bf16x8, pw);
#pragma unroll
      for (int dh = 0; dh < 2; ++dh) {
        const s16x4 lo = trread(vp + dh * dhs + (kh * 32 + 16 * j) * 64), hi = trread(vp + dh * dhs + (kh * 32 + 16 * j + 8) * 64);
        const bf16x8 a = {lo[0], lo[1], lo[2], lo[3], hi[0], hi[1], hi[2], hi[3]};
        st.o[dh] = mfma(a, pb, st.o[dh]);
      }
      st.ls = mfma(ones, pb, st.ls);
    }
}

DEVI void write_o(const f32x16 (&o)[2], float sc, bf16* dst, int g) {
#pragma unroll
  for (int dh = 0; dh < 2; ++dh)
#pragma unroll
    for (int r4 = 0; r4 < 4; ++r4) {
      u32x2 w; w.x = cvtpk(o[dh][4 * r4] * sc, o[dh][4 * r4 + 1] * sc); w.y = cvtpk(o[dh][4 * r4 + 2] * sc, o[dh][4 * r4 + 3] * sc);
      *(u32x2*)(dst + 32 * dh + 8 * r4 + 4 * g) = w;
    }
}

constexpr int AT_BUF = 17408, AT_V = 9216;

struct KVRegs { u32x4 k, v; };
DEVI void kv_load(KVRegs& r, const bf16* __restrict__ Kp, const bf16* __restrict__ Vp, int tok0, int tid) {
  const int row = tid >> 3, ch = tid & 7;
  r.k = *(const u32x4*)(Kp + (size_t)(tok0 + row) * NQKV + ch * 8);
  r.v = *(const u32x4*)(Vp + (size_t)(tok0 + row) * NQKV + ch * 8);
}
DEVI void kv_store(const KVRegs& r, lchar* buf, int tid) {
  const int row = tid >> 3, ch = tid & 7;
  *(LAS u32x4*)(buf + row * 144 + ch * 16) = r.k;
  *(LAS u32x4*)(buf + AT_V + (ch >> 2) * 4096 + row * 64 + (ch & 3) * 16) = r.v;
}

template <int NKS>
DEVI void attn_full_loop(const bf16* __restrict__ QKV, int seqbase, int tokq, int qcol, int kcol, int vcol, int kdimofs, FState& st, lchar* lds) {
  const int tid = otid(), lane = tid & 63, l32 = lane & 31, g = lane >> 5;
  bf16x8 qf[NKS];
#pragma unroll
  for (int ks = 0; ks < NKS; ++ks) qf[ks] = *(const bf16x8*)(QKV + (size_t)tokq * NQKV + qcol + 16 * ks + 8 * g);
  const bf16* Kp = QKV + kcol;
  const bf16* Vp = QKV + vcol;
  KVRegs kra, krb;
  __syncthreads();
  kv_load(kra, Kp, Vp, seqbase, tid);
  kv_load(krb, Kp, Vp, seqbase + 64, tid);
  kv_store(kra, lds, tid);
  __syncthreads();
  constexpr int NT = SEQ / 64;
#define ATT_TILE(buf) do { f32x16 s[2]; \
    _Pragma("unroll") for (int kh = 0; kh < 2; ++kh) { _Pragma("unroll") for (int ks = 0; ks < NKS; ++ks) { \
      const bf16x8 a_ = *(const LAS bf16x8*)((buf) + (kh * 32 + l32) * 144 + kdimofs + ks * 32 + g * 16); \
      s[kh] = mfma(a_, qf[ks], ks == 0 ? st.negm : s[kh]); } } \
    flash_update<2>(s, st, (buf) + AT_V, 4096, lane); } while (0)
  for (int t = 0; t < NT; t += 2) {
    if (t + 2 < NT) kv_load(kra, Kp, Vp, seqbase + (t + 2) * 64, tid);
    ATT_TILE(lds);
    kv_store(krb, lds + AT_BUF, tid);
    __syncthreads();
    if (t + 3 < NT) kv_load(krb, Kp, Vp, seqbase + (t + 3) * 64, tid);
    ATT_TILE(lds + AT_BUF);
    if (t + 2 < NT) kv_store(kra, lds, tid);
    __syncthreads();
  }
#undef ATT_TILE
}

DEVI void attn_A(const Params& p, int layer, int it, lchar* lds) {
  const int seq = it >> 8, h = (it >> 6) & 3, qb = it & 63;
  const int tid = otid(), lane = tid & 63, wave = tid >> 6, l32 = lane & 31, g = lane >> 5;
  const int c = wave & 1, qh = wave >> 1;
  const bf16* QKV = (const bf16*)(p.ws + WS_QKV);
  bf16* O = (bf16*)(p.ws + WS_O);
  const int tokq = seq * SEQ + qb * 128 + qh * 32 + l32;
  FState st; fstate_init(st);
  attn_full_loop<2>(QKV, seq * SEQ, tokq, 64 * h + 32 * c, 256 + 64 * h, 512 + 64 * h, 64 * c, st, lds);
  f32x16 (&o)[2] = st.o;
  const float* lv = p.diff_lambda + layer * 128;
  float d1 = 0.f, d2 = 0.f;
#pragma unroll
  for (int i = 0; i < 32; ++i) { d1 += lv[i] * lv[32 + i]; d2 += lv[64 + i] * lv[96 + i]; }
  const float lam_init = p.lam_init[layer];
  const float lam = expf(d1) - expf(d2) + lam_init;
  const float lt = st.ls[0];
  const float sc = (c == 0) ? 1.0f / lt : lam / lt;
  LAS float* xb = (LAS float*)lds + qh * 2048;
  if (c == 1) {
#pragma unroll
    for (int dh = 0; dh < 2; ++dh)
#pragma unroll
      for (int r = 0; r < 16; ++r) xb[(dh * 16 + r) * 64 + lane] = o[dh][r] * sc;
  }
  __syncthreads();
  if (c == 0) {
    float ss = 0.f;
#pragma unroll
    for (int dh = 0; dh < 2; ++dh)
#pragma unroll
      for (int r = 0; r < 16; ++r) { const float x = o[dh][r] * sc - xb[(dh * 16 + r) * 64 + lane]; o[dh][r] = x; ss += x * x; }
    ss += __shfl_xor(ss, 32);
    const float rstd = (1.0f - lam_init) / sqrtf(ss * (1.0f / 64.0f) + EPS);
    const float* sg = p.diff_subln + layer * 64;
#pragma unroll
    for (int dh = 0; dh < 2; ++dh)
#pragma unroll
      for (int r = 0; r < 16; ++r) o[dh][r] *= sg[32 * dh + crow(r, g)];
    write_o(o, rstd, O + (size_t)tokq * DM + 64 * h, g);
  }
}

DEVI void attn_D(const Params& p, int it, lchar* lds) {
  const int seq = it >> 7, kv = (it >> 6) & 1, qb = it & 63;
  const int tid = otid(), lane = tid & 63, wave = tid >> 6, l32 = lane & 31, g = lane >> 5;
  const bf16* QKV = (const bf16*)(p.ws + WS_QKV);
  bf16* O = (bf16*)(p.ws + WS_O);
  const int hq = 2 * kv + (wave & 1);
  const int tokq = seq * SEQ + qb * 128 + (wave >> 1) * 32 + l32;
  FState st; fstate_init(st);
  attn_full_loop<4>(QKV, seq * SEQ, tokq, 2304 + 64 * hq, 2560 + 64 * kv, 2688 + 64 * kv, 0, st, lds);
  const float lt = st.ls[0];
  write_o(st.o, 1.0f / lt, O + (size_t)tokq * DM + 768 + 64 * hq, g);
}

constexpr int ATB_BIAS = 8 * AT_BUF;
struct KVRegs4 { u32x4 k[4], v[4]; };
DEVI void kvb_load(KVRegs4& r, const bf16* __restrict__ QKV, int tok0, int tid) {
  const int hd = tid >> 7, t7 = tid & 127;
#pragma unroll
  for (int i = 0; i < 4; ++i) {
    const int c = t7 + 128 * i, row = c >> 3, ch = c & 7;
    r.k[i] = *(const u32x4*)(QKV + (size_t)(tok0 + row) * NQKV + 1024 + 64 * hd + ch * 8);
    r.v[i] = *(const u32x4*)(QKV + (size_t)(tok0 + row) * NQKV + 1280 + 64 * hd + ch * 8);
  }
}
DEVI void kvb_store(const KVRegs4& r, lchar* lds, int bufsel, int tid) {
  const int hd = tid >> 7, t7 = tid & 127;
  lchar* buf = lds + (hd * 2 + bufsel) * AT_BUF;
#pragma unroll
  for (int i = 0; i < 4; ++i) {
    const int c = t7 + 128 * i, row = c >> 3, ch = c & 7;
    *(LAS u32x4*)(buf + row * 144 + ch * 16) = r.k[i];
    *(LAS u32x4*)(buf + AT_V + (ch >> 2) * 4096 + row * 64 + (ch & 3) * 16) = r.v[i];
  }
}
DEVI void attn_B(const Params& p, int layer, int it, lchar* lds) {
  const int seq = it >> 7, r = it & 127;
  const int tid = otid(), lane = tid & 63, wave = tid >> 6, l32 = lane & 31, g = lane >> 5;
  const int h = wave >> 1;
  const bf16* QKV = (const bf16*)(p.ws + WS_QKV);
  bf16* O = (bf16*)(p.ws + WS_O);
  const int qc = (wave & 1) * 32 + l32;
  const int tokq = seq * SEQ + r * 64 + qc;
  bf16x8 qf[4];
#pragma unroll
  for (int ks = 0; ks < 4; ++ks) qf[ks] = *(const bf16x8*)(QKV + (size_t)tokq * NQKV + 768 + 64 * h + 16 * ks + 8 * g);
  int rs = r - 4; rs = rs < 0 ? 0 : (rs > 120 ? 120 : rs);
  const int tokk = seq * SEQ + rs * 64;
  LAS float* bias = (LAS float*)(lds + ATB_BIAS) + h * 465;
  const float* rpb = p.na_rpb + (size_t)(layer * 4) * 465;
  FState st; fstate_init(st);
  int cs = qc - 8; cs = cs < 0 ? 0 : (cs > 48 ? 48 : cs);
  __syncthreads();
  for (int i = tid; i < 4 * 465; i += NTHR) ((LAS float*)(lds + ATB_BIAS))[i] = rpb[i] * LOG2E;
  for (int t = 0; t < 8; ++t) {
    __syncthreads();
    { KVRegs4 kr; kvb_load(kr, QKV, tokk + t * 64, tid); kvb_store(kr, lds, 0, tid); }
    __syncthreads();
    lchar* buf = lds + (h * 2) * AT_BUF;
    const int dr = rs + t - r + 7;
    f32x16 s[2];
#pragma unroll
    for (int kh = 0; kh < 2; ++kh) {
#pragma unroll
      for (int ks = 0; ks < 4; ++ks) {
        const bf16x8 a = *(const LAS bf16x8*)(buf + (kh * 32 + l32) * 144 + ks * 32 + g * 16);
        s[kh] = mfma(a, qf[ks], ks == 0 ? st.negm : s[kh]);
      }
#pragma unroll
      for (int rr = 0; rr < 16; ++rr) {
        const int kc = kh * 32 + crow(rr, g);
        int dc = kc - qc + 15; dc = dc < 0 ? 0 : (dc > 30 ? 30 : dc);
        const bool valid = (kc >= cs) && (kc < cs + 16);
        s[kh][rr] = valid ? s[kh][rr] + bias[dr * 31 + dc] : -INFINITY;
      }
    }
    flash_update<2>(s, st, buf + AT_V, 4096, lane);
  }
  const float lt = st.ls[0];
  write_o(st.o, 1.0f / lt, O + (size_t)tokq * DM + 256 + 64 * h, g);
}

constexpr int CW_BUF = 8704, CW_V = 4608;
struct CRegs { u32x4 k[4], v[4]; };
DEVI void c_tile_params(int tg, int& st, int& j0) {
  if (tg < 5) { st = 16; j0 = -64 + 32 * tg; }
  else if (tg < 13) { st = 4; j0 = -64 + 32 * (tg - 5); }
  else { st = 1; j0 = -64 + 32 * (tg - 13); }
}
DEVI void c_load(CRegs& r, const bf16* __restrict__ Kp, const bf16* __restrict__ Vp, int seqbase, int qp0, int tg, int lane) {
  int st, j0; c_tile_params(tg, st, j0);
#pragma unroll
  for (int i = 0; i < 4; ++i) {
    const int c = lane + 64 * i, row = c >> 3, ch = c & 7;
    int kp = qp0 + st * (j0 + row); kp = kp < 0 ? 0 : (kp > SEQ - 1 ? SEQ - 1 : kp);
    r.k[i] = *(const u32x4*)(Kp + (size_t)(seqbase + kp) * NQKV + ch * 8);
    r.v[i] = *(const u32x4*)(Vp + (size_t)(seqbase + kp) * NQKV + ch * 8);
  }
}
DEVI void c_store(const CRegs& r, lchar* wb, int lane) {
#pragma unroll
  for (int i = 0; i < 4; ++i) {
    const int c = lane + 64 * i, row = c >> 3, ch = c & 7;
    *(LAS u32x4*)(wb + row * 144 + ch * 16) = r.k[i];
    *(LAS u32x4*)(wb + CW_V + (ch >> 2) * 2048 + row * 64 + (ch & 3) * 16) = r.v[i];
  }
}
DEVI void attn_C(const Params& p, int it, lchar* lds) {
  const int seq = it >> 7, h = (it >> 5) & 3, span = (it >> 1) & 15, half = it & 1;
  const int tid = otid(), lane = tid & 63, wave = tid >> 6, l32 = lane & 31, g = lane >> 5;
  const bf16* QKV = (const bf16*)(p.ws + WS_QKV);
  bf16* O = (bf16*)(p.ws + WS_O);
  const int rho = half * 8 + wave, qp0 = span * 512 + rho;
  const int seqbase = seq * SEQ;
  const int tokq = seqbase + qp0 + 16 * l32;
  bf16x8 qf[4];
#pragma unroll
  for (int ks = 0; ks < 4; ++ks) qf[ks] = *(const bf16x8*)(QKV + (size_t)tokq * NQKV + 1536 + 64 * h + 16 * ks + 8 * g);
  const bf16* Kp = QKV + 1792 + 64 * h;
  const bf16* Vp = QKV + 2048 + 64 * h;
  lchar* wb = lds + wave * CW_BUF;
  FState fs; fstate_init(fs);
  CRegs cr;
  c_load(cr, Kp, Vp, seqbase, qp0, 0, lane);
  __syncthreads();
  for (int tg = 0; tg < 33; ++tg) {
    asm volatile("" ::: "memory");
    c_store(cr, wb, lane);
    asm volatile("s_waitcnt lgkmcnt(0)" ::: "memory");
    if (tg + 1 < 33) c_load(cr, Kp, Vp, seqbase, qp0, tg + 1, lane);
    int st, j0; c_tile_params(tg, st, j0);
    f32x16 s[1];
#pragma unroll
    for (int ks = 0; ks < 4; ++ks) {
      const bf16x8 a = *(const LAS bf16x8*)(wb + l32 * 144 + ks * 32 + g * 16);
      s[0] = mfma(a, qf[ks], ks == 0 ? fs.negm : s[0]);
    }
#pragma unroll
    for (int rr = 0; rr < 16; ++rr) {
      const int jj = j0 + crow(rr, g);
      const int kp = qp0 + st * jj;
      int dd = 16 * l32 - st * jj; dd = dd < 0 ? -dd : dd;
      const bool valid = (dd <= 64 * st) && (kp >= 0) && (kp < SEQ);
      s[0][rr] = valid ? s[0][rr] : -INFINITY;
    }
    flash_update<1>(s, fs, wb + CW_V, 2048, lane);
  }
  const float lt = fs.ls[0];
  write_o(fs.o, 1.0f / lt, O + (size_t)tokq * DM + 512 + 64 * h, g);
}

DEVI void phase_attn(const Params& p, int layer, lchar* lds) {
  constexpr int NA = NSEQ * 4 * 64, ND = NSEQ * 2 * 64, NB = NSEQ * 128, NC = NSEQ * 4 * 16 * 2;
  for (int i = 0;; ++i) {
    const int it = xsched_idx(i); if (it >= NA + ND + NB + NC) break;
    if (it < NA) attn_A(p, layer, it, lds);
    else if (it < NA + ND) attn_D(p, it - NA, lds);
    else if (it < NA + ND + NB) attn_B(p, layer, it - NA - ND, lds);
    else attn_C(p, it - NA - ND - NB, lds);
    __syncthreads();
  }
}

DEVI void phase_merge(const Params& p, int layer, lchar* lds) {
  const bf16* H = (const bf16*)(p.ws + WS_H);
  const bf16* Ob = (const bf16*)(p.ws + WS_O);
  const bf16* Wt = (const bf16*)(p.ws + WS_WIN) + (size_t)layer * INC * DM;
  const bf16* Wb = (const bf16*)(p.ws + WS_WB) + (size_t)layer * 4 * DM * 256;
  bf16* MG = (bf16*)(p.ws + WS_QKV);
  constexpr int NT = 4, MT = MTOK / 128, TILES = MT * NT;
  for (int i = 0;; ++i) {
    const int idx = xsched_idx(i); if (idx >= TILES) break;
    const int tid = otid();
    int mt, nt; gemm_tile(idx, MT, NT, mt, nt);
    const int m0 = mt * 128, n0 = nt * 256;
    unsigned mgp[2][2][8];
#pragma unroll
    for (int mi = 0; mi < 2; ++mi)
#pragma unroll
      for (int ni = 0; ni < 2; ++ni)
#pragma unroll
        for (int j = 0; j < 8; ++j) mgp[mi][ni][j] = 0u;
    for (int b = 0; b < 4; ++b) {
      f32x16 acc[2][2]; zero_acc<2>(acc);
      const int gr = NQKV + b * DM + n0;
      gemm_dma<2, true>(acc, lds, H, DM, m0, 0, MTOK - 1, Wt, DM, gr, gr + 128, DM,
                        b > 0, Ob + 256 * b, DM, Wb + (size_t)b * DM * 256, 256, n0, n0 + 128);
      unsigned sg[2][2][8];
#pragma unroll
      for (int mi = 0; mi < 2; ++mi)
#pragma unroll
        for (int ni = 0; ni < 2; ++ni)
#pragma unroll
          for (int j = 0; j < 8; ++j) {
            const float s0 = __builtin_amdgcn_rcpf(1.0f + ex2(-acc[mi][ni][2 * j] * LOG2E));
            const float s1 = __builtin_amdgcn_rcpf(1.0f + ex2(-acc[mi][ni][2 * j + 1] * LOG2E));
            sg[mi][ni][j] = cvtpk(s0, s1);
          }
      zero_acc<2>(acc);
      gemm_dma<2, true>(acc, lds, Ob + 256 * b, DM, m0, 0, MTOK - 1, Wb + (size_t)b * DM * 256, 256, n0, n0 + 128, 256,
                        true, b < 3 ? H : nullptr, DM, Wt, DM, gr + DM, gr + DM + 128);
#pragma unroll
      for (int mi = 0; mi < 2; ++mi)
#pragma unroll
        for (int ni = 0; ni < 2; ++ni)
#pragma unroll
          for (int j = 0; j < 8; ++j) {
            const unsigned w = sg[mi][ni][j], mo = mgp[mi][ni][j];
            const float lo = __uint_as_float(mo << 16) + __uint_as_float(w << 16) * acc[mi][ni][2 * j];
            const float hi = __uint_as_float(mo & 0xffff0000u) + __uint_as_float(w & 0xffff0000u) * acc[mi][ni][2 * j + 1];
            mgp[mi][ni][j] = cvtpk(lo, hi);
          }
    }
    f32x16 mg[2][2];
#pragma unroll
    for (int mi = 0; mi < 2; ++mi)
#pragma unroll
      for (int ni = 0; ni < 2; ++ni)
#pragma unroll
        for (int j = 0; j < 8; ++j) { mg[mi][ni][2 * j] = __uint_as_float(mgp[mi][ni][j] << 16); mg[mi][ni][2 * j + 1] = __uint_as_float(mgp[mi][ni][j] & 0xffff0000u); }
    acc_to_lds(mg, lds);
    __syncthreads();
    {
      const LAS float* Cs = (const LAS float*)lds;
#pragma unroll
      for (int k = 0; k < 8; ++k) {
        const int id = tid + 512 * k, row = id >> 5, ch = id & 31;
        const f32x4 a = *(const LAS f32x4*)(Cs + row * CP + ch * 8), b2 = *(const LAS f32x4*)(Cs + row * CP + ch * 8 + 4);
        u32x4 o; o.x = cvtpk(a.x, a.y); o.y = cvtpk(a.z, a.w); o.z = cvtpk(b2.x, b2.y); o.w = cvtpk(b2.z, b2.w);
        *(u32x4*)(MG + (size_t)(m0 + row) * DM + n0 + ch * 8) = o;
      }
    }
    __syncthreads();
  }
}

DEVI void phase_resid(const Params& p, float* xout, const bf16* A, int lda, const bf16* Wt, int K, lchar* lds, bool fuse) {
  bf16* Hn = (bf16*)(p.ws + WS_H);
  float* PART = (float*)(p.ws + WS_PART);
  const int tid = otid();
  constexpr int NT = 4, MT = MTOK / 256, TILES = MT * NT;
  for (int i = 0;; ++i) {
    const int idx = xsched_idx(i); if (idx >= TILES) break;
    int mt, nt; gemm_tile(idx, MT, NT, mt, nt);
    const int n0 = nt * 256;
    f32x16 acc[4][2]; zero_acc<4>(acc);
    gemm_dma<4>(acc, lds, A, lda, mt * 256, 0, MTOK - 1, Wt, K, n0, n0 + 128, K);
    for (int hf = 0; hf < 2; ++hf) {
      const int m0 = mt * 256 + hf * 128;
      acc_to_lds_half(acc, lds, hf, 0);
      __syncthreads();
      const LAS float* Cs = (const LAS float*)lds;
#pragma unroll 8
      for (int k = 0; k < 16; ++k) {
        const int id = tid + 512 * k, row = id >> 6, c4 = id & 63;
        const f32x4 a = *(const LAS f32x4*)(Cs + row * CP + c4 * 4);
        f32x4* xp = (f32x4*)(xout + (size_t)(m0 + row) * DM + n0 + c4 * 4);
        const f32x4 xn = *xp + a;
        *xp = xn;
        if (fuse) {
          u32x2 hb; hb.x = cvtpk(xn.x, xn.y); hb.y = cvtpk(xn.z, xn.w);
          *(u32x2*)(Hn + (size_t)(m0 + row) * DM + n0 + c4 * 4) = hb;
          const float ssr = wave_sum((xn.x * xn.x + xn.y * xn.y) + (xn.z * xn.z + xn.w * xn.w));
          if ((tid & 63) == 0) PART[(size_t)nt * MTOK + m0 + row] = ssr;
        }
      }
      __syncthreads();
    }
  }
}

DEVI float gelu_exact(float v) {
  const float av = fabsf(v), t = __builtin_amdgcn_rcpf(av * 0.2316418882f + 1.0f);
  float q = t * 0.5307027145f + (-0.7265760135f); q = q * t + 0.7107068705f; q = q * t + (-0.142248368f); q = q * t + 0.127414796f; q = q * t;
  const float e = ex2((v * v) * (-0.72134752044f));
  const float mm = v * (q * e);
  return v < 0.f ? mm : v - mm;
}
DEVI void phase_up(const Params& p, int layer, lchar* lds) {
  const bf16* H = (const bf16*)(p.ws + WS_H);
  const bf16* Wt = (const bf16*)(p.ws + WS_WUP) + (size_t)layer * NUP * DM;
  bf16* ACT = (bf16*)(p.ws + WS_QKV);
  const float* cw = p.conv_w + (size_t)layer * 3 * NUP;
  const float* cb = p.conv_b + (size_t)layer * NUP;
  const int tid = otid(), lane = tid & 63, wave = __builtin_amdgcn_readfirstlane(tid >> 6), wr = wave >> 2, wc = wave & 3, l32 = lane & 31, g = lane >> 5;
  constexpr int MT = 33, NT = 22, SMT = NSEQ * MT, TILES = ((SMT + 3) / 4) * 4 * NT;
  for (int i = 0;; ++i) {
    const int idx = xsched_idx(i); if (idx >= TILES) break;
    int sm, nt; if (!gemm_tile(idx, SMT, NT, sm, nt)) continue;
    const int seq = sm / MT, mt = sm - seq * MT;
    const int seqbase = seq * SEQ, p0 = 254 * mt - 1;
    f32x16 acc[4][2]; zero_acc<4>(acc);
    if (tid < 256) { int rr = p0 + tid; rr = rr < 0 ? 0 : (rr > SEQ - 1 ? SEQ - 1 : rr); ((LAS float*)(lds + RS_OFF4))[tid] = row_rstd(p, seqbase + rr); }
    gemm_dma<4>(acc, lds, H, DM, seqbase + p0, seqbase, seqbase + SEQ - 1, Wt, DM, 128 * nt, DFF + 128 * nt, DM);
    for (int hf = 0; hf < 2; ++hf) {
      LAS float* Cw = (LAS float*)lds;
      acc_to_lds_half(acc, lds, hf, hf);
      if (hf == 0 && wr == 1 && g == 0) {
#pragma unroll
        for (int ni = 0; ni < 2; ++ni) Cw[128 * CP + wc * 64 + ni * 32 + l32] = acc[0][ni][0];
      }
      if (hf == 1 && wr == 0 && g == 1) {
#pragma unroll
        for (int ni = 0; ni < 2; ++ni) Cw[wc * 64 + ni * 32 + l32] = acc[3][ni][15];
      }
      __syncthreads();
      const LAS float* Cs = (const LAS float*)lds;
#pragma unroll 1
      for (int k = 0; k < 4; ++k) {
        const int id = tid + 512 * k, lr = 1 + (id >> 4), ch = id & 15, pp = p0 + 127 * hf + lr;
        if (lr <= 127 && pp < SEQ) {
          const int c0 = 128 * nt + ch * 8;
          const LAS float* rsl = (const LAS float*)(lds + RS_OFF4) + 127 * hf + lr;
          const float rc = rsl[0], wp = pp > 0 ? rsl[-1] : 0.f, wn = pp < SEQ - 1 ? rsl[1] : 0.f;
#pragma unroll 1
          for (int hh = 0; hh < 2; ++hh) {
            const f32x4 um = *(const LAS f32x4*)(Cs + (lr - 1) * CP + ch * 8 + 4 * hh), uc = *(const LAS f32x4*)(Cs + lr * CP + ch * 8 + 4 * hh),
                        un = *(const LAS f32x4*)(Cs + (lr + 1) * CP + ch * 8 + 4 * hh);
            const f32x4 w0 = *(const f32x4*)(cw + c0 + 4 * hh), w1 = *(const f32x4*)(cw + NUP + c0 + 4 * hh), w2 = *(const f32x4*)(cw + 2 * NUP + c0 + 4 * hh), bb = *(const f32x4*)(cb + c0 + 4 * hh);
            const f32x4 val = um * w0 * wp + uc * w1 * rc + un * w2 * wn + bb;
            const f32x4 gm = *(const LAS f32x4*)(Cs + (lr - 1) * CP + 128 + ch * 8 + 4 * hh), gc = *(const LAS f32x4*)(Cs + lr * CP + 128 + ch * 8 + 4 * hh),
                        gn = *(const LAS f32x4*)(Cs + (lr + 1) * CP + 128 + ch * 8 + 4 * hh);
            const f32x4 v0 = *(const f32x4*)(cw + DFF + c0 + 4 * hh), v1 = *(const f32x4*)(cw + NUP + DFF + c0 + 4 * hh), v2 = *(const f32x4*)(cw + 2 * NUP + DFF + c0 + 4 * hh), vb = *(const f32x4*)(cb + DFF + c0 + 4 * hh);
            const f32x4 gt = gm * v0 * wp + gc * v1 * rc + gn * v2 * wn + vb;
            u32x2 o; o.x = cvtpk(gelu_exact(gt.x) * val.x, gelu_exact(gt.y) * val.y); o.y = cvtpk(gelu_exact(gt.z) * val.z, gelu_exact(gt.w) * val.w);
            *(u32x2*)(ACT + (size_t)(seqbase + pp) * DFF + c0 + 4 * hh) = o;
          }
        }
      }
      __syncthreads();
    }
  }
}

#define XB_TMO      128
#define XB_XCNT(j)  (256  + 64 * (j))
#define XB_XSUB(j)  (1280 + 64 * (j))
#define XB_XGEN(j)  (2304 + 64 * (j))
#define XB_TOP      3328
#define XB_TOPGEN   3392
#define XCD_BAR_WORDS 3456
#define XB_SPIN_CAP (1u << 22)
DEVI unsigned xb_ld(unsigned* p)              { return __hip_atomic_load(p, __ATOMIC_RELAXED, __HIP_MEMORY_SCOPE_AGENT); }
DEVI unsigned xb_add(unsigned* p, unsigned v) { return __hip_atomic_fetch_add(p, v, __ATOMIC_RELAXED, __HIP_MEMORY_SCOPE_AGENT); }
DEVI unsigned xb_xcc_id() { return (unsigned)__builtin_amdgcn_s_getreg((3 << 11) | 20) & 0xFu; }
#define XB_SPIN(cond, bar) do { unsigned _sp = 0; while (cond) { __builtin_amdgcn_s_sleep(1); \
    if ((++_sp & 255u) == 0u) { if (xb_ld(&(bar)[XB_TMO])) break; if (_sp > XB_SPIN_CAP) { atomicAdd(&(bar)[XB_TMO], 1u); break; } } } } while (0)
struct XcdBarrier { unsigned* bar; unsigned x; volatile LAS unsigned* st; };
DEVI XcdBarrier xcd_barrier_post(unsigned* bar, volatile LAS unsigned* st) {
  XcdBarrier b; b.bar = bar; b.x = xb_xcc_id(); b.st = st;
  if (threadIdx.x == 0) (void)xb_add(&bar[XB_XCNT(b.x)], 1u);
  return b;
}
DEVI void xcd_barrier_complete(unsigned* bar, unsigned x, unsigned& nloc, unsigned& nx) {
  const unsigned G = gridDim.x * gridDim.y * gridDim.z;
  unsigned sum, cnt, mine, sp = 0u;
  for (;;) {
    sum = 0u; cnt = 0u; mine = 0u;
#pragma unroll
    for (unsigned j = 0; j < 16; ++j) { const unsigned c = xb_ld(&bar[XB_XCNT(j)]); sum += c; cnt += (c > 0u) ? 1u : 0u; mine = (j == x) ? c : mine; }
    if (sum == G) break;
    __builtin_amdgcn_s_sleep(1);
    if ((++sp & 255u) == 0u) { if (xb_ld(&bar[XB_TMO])) break; if (sp > XB_SPIN_CAP) { atomicAdd(&bar[XB_TMO], 1u); break; } }
  }
  nloc = mine > 0u ? mine : 1u; nx = cnt > 0u ? cnt : 1u;
}
DEVI void xcd_barrier(const XcdBarrier& b) {
  asm volatile("s_waitcnt vmcnt(0)" ::: "memory");
  __syncthreads();
  if (threadIdx.x == 0) {
    unsigned* bar = b.bar;
    __builtin_amdgcn_s_waitcnt(0);
    unsigned nloc = b.st[0], nx = b.st[1];
    if (nloc == 0u) { xcd_barrier_complete(bar, b.x, nloc, nx); b.st[0] = nloc; b.st[1] = nx; }
    const unsigned old = xb_add(&bar[XB_XSUB(b.x)], 1u);
    const unsigned gen = old / nloc;
    if (old + 1u == (gen + 1u) * nloc) {
      __builtin_amdgcn_fence(__ATOMIC_RELEASE, "agent");
      asm volatile("s_waitcnt vmcnt(0)" ::: "memory");
      const unsigned og = xb_add(&bar[XB_TOP], 1u);
      const unsigned tg = og / nx;
      if (og + 1u == (tg + 1u) * nx) xb_add(&bar[XB_TOPGEN], 1u);
      else XB_SPIN(xb_ld(&bar[XB_TOPGEN]) == tg, bar);
      __builtin_amdgcn_fence(__ATOMIC_ACQUIRE, "agent");
      xb_add(&bar[XB_XGEN(b.x)], 1u);
      asm volatile("s_waitcnt vmcnt(0)" ::: "memory");
    } else {
      XB_SPIN(xb_ld(&bar[XB_XGEN(b.x)]) == gen, bar);
      __builtin_amdgcn_fence(__ATOMIC_ACQUIRE, "agent");
      asm volatile("s_waitcnt vmcnt(0)" ::: "memory");
    }
  }
  __syncthreads();
}

constexpr int NPHASE = 17;
__global__ void __launch_bounds__(NTHR, 2) fwd_kernel(Params p) {
  __shared__ __attribute__((aligned(16))) char lds_raw[LDS_BYTES];
  __shared__ unsigned xb_state[2];
  lchar* lds = (lchar*)lds_raw;
  if (threadIdx.x < 2) xb_state[threadIdx.x] = 0u;
  __syncthreads();
  if (p.nseq == 12345) cg::this_grid().sync();
  const XcdBarrier xbar = xcd_barrier_post((unsigned*)(p.ws + WS_CTL), (volatile LAS unsigned*)xb_state);
#define GRID_SYNC() xcd_barrier(xbar)
  for (int i = 0; i < p.nseq; ++i) {
    if (i) GRID_SYNC();
    const int ph = (int)(((i < 12) ? (p.seq0 >> (5 * i)) : (p.seq1 >> (5 * (i - 12)))) & 31ull);
    if (ph == 0) { phase_weights(p, lds); phase_norm(p, 0, p.norm_attn); continue; }
    const int layer = (ph - 1) >> 3, sub = (ph - 1) & 7;
    switch (sub) {
      case 0: phase_qkv(p, layer, lds); break;
      case 1: phase_attn(p, layer, lds); break;
      case 2: phase_merge(p, layer, lds); break;
      case 3: phase_resid(p, p.out, (const bf16*)(p.ws + WS_QKV), DM, (const bf16*)(p.ws + WS_WOUT) + (size_t)layer * DM * DM, DM, lds, true); break;
      case 4: phase_norm(p, 1, p.norm_mlp + layer * DM); break;
      case 5: phase_up(p, layer, lds); break;
      case 6: phase_resid(p, p.out, (const bf16*)(p.ws + WS_QKV), DFF, (const bf16*)(p.ws + WS_WDN) + (size_t)layer * DM * DFF, DFF, lds, false); break;
      default: if (layer == 0) phase_norm(p, 1, p.norm_attn + DM); else phase_norm(p, 2, p.norm_final); break;
    }
  }
}

extern "C" void kernel_launch(void* const* d_in, const int* in_sizes, int n_in, void* d_out, int out_size, void* d_ws, size_t ws_size, hipStream_t stream) {
  static int grid = 0;
  if (grid == 0) {
    if (n_in != 16 || out_size != MTOK * DM || ws_size < WS_END) { fprintf(stderr, "kernel_launch: unexpected shapes (n_in %d out %d ws %zu need %zu)\n", n_in, out_size, ws_size, (size_t)WS_END); grid = -1; return; }
    int dev = 0, cus = 0, per_cu = 0;
    hipGetDevice(&dev);
    hipDeviceGetAttribute(&cus, hipDeviceAttributeMultiprocessorCount, dev);
    hipOccupancyMaxActiveBlocksPerMultiprocessor(&per_cu, fwd_kernel, NTHR, 0);
    if (per_cu < 1) per_cu = 1;
    if (per_cu > 1) per_cu = 1;
    grid = (cus * per_cu) & ~7;
    if (grid < 8) grid = -1;
  }
  if (grid < 0) return;
  Params p{};
  p.xp = (const float*)d_in[0]; p.xs = (const float*)d_in[1]; p.norm_attn = (const float*)d_in[2]; p.w_in = (const float*)d_in[3];
  p.diff_lambda = (const float*)d_in[4]; p.diff_subln = (const float*)d_in[5]; p.na_rpb = (const float*)d_in[6]; p.qk_norm = (const float*)d_in[7];
  p.w_branch = (const float*)d_in[8]; p.w_out = (const float*)d_in[9]; p.norm_mlp = (const float*)d_in[10]; p.w_up = (const float*)d_in[11];
  p.conv_w = (const float*)d_in[12]; p.conv_b = (const float*)d_in[13]; p.w_down = (const float*)d_in[14]; p.norm_final = (const float*)d_in[15];
  p.out = (float*)d_out; p.ws = (char*)d_ws;
  const double TWO_PI = 6.283185307179586476925286766559;
  for (int i = 0; i < 4; ++i) p.invA[i] = std::exp(-std::log(500000.0) * i / 4.0) / TWO_PI;
  for (int i = 0; i < 8; ++i) p.invC[i] = std::exp(-std::log(500000.0) * i / 8.0) / TWO_PI;
  for (int i = 0; i < 16; ++i) p.invD[i] = std::exp(-std::log(10000.0) * i / 16.0) / TWO_PI;
  for (int l = 0; l < 2; ++l) p.lam_init[l] = (float)(0.8 - 0.6 * std::exp(-0.3 * l));
  if (hipMemsetAsync((char*)d_ws + WS_CTL, 0, CTL_BYTES, stream) != hipSuccess) { fprintf(stderr, "kernel_launch: memset of barrier words failed\n"); return; }
  int codes[24]; int n = 0;
  for (int ph = 0; ph < NPHASE; ++ph) { if (ph == 5 || ph == 13) continue; codes[n++] = ph; if (ph > 0 && ((PROBE_DUP >> ((ph - 1) & 7)) & 1)) codes[n++] = ph; }
  p.nseq = n; p.seq0 = 0; p.seq1 = 0;
  for (int i = 0; i < n; ++i) { if (i < 12) p.seq0 |= (unsigned long long)codes[i] << (5 * i); else p.seq1 |= (unsigned long long)codes[i] << (5 * (i - 12)); }
  void* args[] = {&p};
  hipError_t e = hipLaunchCooperativeKernel((void*)fwd_kernel, dim3(grid), dim3(NTHR), args, 0, stream);
  if (e != hipSuccess) fprintf(stderr, "cooperative launch failed: %s (grid %d)\n", hipGetErrorString(e), grid);
}
```

```cpp
#include <hip/hip_runtime.h>
#include <hip/hip_cooperative_groups.h>
#include <cstdio>
#include <cmath>
namespace cg = cooperative_groups;

#ifndef MEGA
#define MEGA 1
#endif

#ifndef PROBE_DUP
#define PROBE_DUP 0
#endif
#define DEVI __device__ __forceinline__
#define LAS __attribute__((address_space(3)))
typedef unsigned short bf16;
typedef short bf16x8 __attribute__((ext_vector_type(8)));
typedef short s16x4 __attribute__((ext_vector_type(4)));
typedef float f32x16 __attribute__((ext_vector_type(16)));
typedef float f32x4 __attribute__((ext_vector_type(4)));
typedef float f32x2_t __attribute__((ext_vector_type(2)));
typedef __bf16 bf16x2_t __attribute__((ext_vector_type(2)));
typedef unsigned u32x4 __attribute__((ext_vector_type(4)));
typedef unsigned u32x2 __attribute__((ext_vector_type(2)));
typedef LAS char lchar;

constexpr int DM = 1024, SEQ = 8192, NSEQ = 10, MTOK = NSEQ * SEQ, NQKV = 2816, INC = 6912, DFF = 2816, NUP = 5632;
constexpr float LOG2E = 1.4426950408889634f;
constexpr float EPS = 1e-6f;
constexpr int NTHR = 512;
constexpr int LDS_BYTES = 147456;
constexpr int CP = 260;

constexpr size_t SZ_WIN = (size_t)2 * INC * DM * 2, SZ_WB = (size_t)2 * 4 * DM * 256 * 2, SZ_WOUT = (size_t)2 * DM * DM * 2,
                 SZ_WUP = (size_t)2 * NUP * DM * 2, SZ_WDN = (size_t)2 * DM * DFF * 2;
constexpr size_t WS_WIN = 0, WS_WB = WS_WIN + SZ_WIN, WS_WOUT = WS_WB + SZ_WB, WS_WUP = WS_WOUT + SZ_WOUT, WS_WDN = WS_WUP + SZ_WUP;
constexpr size_t WS_H = WS_WDN + SZ_WDN;
constexpr size_t WS_O = WS_H + (size_t)MTOK * DM * 2;
constexpr size_t WS_QKV = WS_O + (size_t)MTOK * DM * 2;
constexpr size_t WS_CTL = WS_QKV + (size_t)MTOK * NQKV * 2;
constexpr size_t CTL_BYTES = 16384;
constexpr size_t WS_END = WS_CTL + CTL_BYTES;

struct Params {
  const float *xp, *xs, *norm_attn, *w_in, *diff_lambda, *diff_subln, *na_rpb, *qk_norm, *w_branch, *w_out, *norm_mlp, *w_up, *conv_w, *conv_b, *w_down, *norm_final;
  float* out; char* ws;
  double invA[4], invC[8], invD[16];
  float lam_init[2]; int nseq, pad0;
  unsigned long long seq0, seq1;
};

DEVI unsigned cvtpk(float lo, float hi) { f32x2_t v = {lo, hi}; bf16x2_t b = __builtin_convertvector(v, bf16x2_t); return __builtin_bit_cast(unsigned, b); }
DEVI float bf2f(unsigned short h) { return __uint_as_float(((unsigned)h) << 16); }
DEVI f32x16 mfma(bf16x8 a, bf16x8 b, f32x16 c) { return __builtin_amdgcn_mfma_f32_32x32x16_bf16(a, b, c, 0, 0, 0); }
DEVI int crow(int r, int g) { return (r & 3) + 8 * (r >> 2) + 4 * g; }
DEVI float ex2(float x) { return __builtin_amdgcn_exp2f(x); }
DEVI s16x4 trread(const lchar* p) { return __builtin_bit_cast(s16x4, __builtin_amdgcn_ds_read_tr16_b64_v4i16((LAS s16x4*)p)); }
DEVI int otid() { int t = threadIdx.x; asm volatile("" : "+v"(t)); return t; }
DEVI float wave_sum(float v) {
#pragma unroll
  for (int o = 1; o < 64; o <<= 1) v += __shfl_xor(v, o);
  return v;
}

#define WAITBAR(N) asm volatile("s_waitcnt vmcnt(" #N ") lgkmcnt(0)\n\ts_barrier" ::: "memory")
template <int MI, bool CHAIN = false>
DEVI void gemm_dma(f32x16 (&acc)[MI][2], lchar* lds, const bf16* __restrict__ A, int lda, int arow0, int alo, int ahi,
                   const bf16* __restrict__ B, int ldb, int brow0, int brow1, int K,
                   bool has_prev = false, const bf16* __restrict__ nA = nullptr, int nlda = 0, const bf16* __restrict__ nB = nullptr, int nldb = 0, int nbrow0 = 0, int nbrow1 = 0) {
  constexpr int ABYTES = 64 * MI * 64, STAGE = ABYTES + 16384, NAI = MI / 2;
  const int tid = otid(), lane = tid & 63, wave = __builtin_amdgcn_readfirstlane(tid >> 6), wr = wave >> 2, wc = wave & 3, l32 = lane & 31, g = lane >> 5;
  int offA[NAI], offB[2];
#pragma unroll
  for (int i = 0; i < NAI; ++i) {
    const int r = wave * 8 * MI + 16 * i + (lane >> 2), c = (lane & 3) ^ ((r >> 2) & 3);
    int ar = arow0 + r; ar = ar < alo ? alo : (ar > ahi ? ahi : ar);
    offA[i] = ar * lda + c * 8;
  }
#pragma unroll
  for (int i = 0; i < 2; ++i) {
    const int r = wave * 32 + 16 * i + (lane >> 2), c = (lane & 3) ^ ((r >> 2) & 3);
    const int br = (r < 128) ? brow0 + r : brow1 + r - 128;
    offB[i] = br * ldb + c * 8;
  }
  const bool has_next = CHAIN && (nA != nullptr);
  int noffA[NAI], noffB[2];
  if (CHAIN) {
#pragma unroll
    for (int i = 0; i < NAI; ++i) {
      const int r = wave * 8 * MI + 16 * i + (lane >> 2), c = (lane & 3) ^ ((r >> 2) & 3);
      int ar = arow0 + r; ar = ar < alo ? alo : (ar > ahi ? ahi : ar);
      noffA[i] = ar * nlda + c * 8;
    }
#pragma unroll
    for (int i = 0; i < 2; ++i) {
      const int r = wave * 32 + 16 * i + (lane >> 2), c = (lane & 3) ^ ((r >> 2) & 3);
      const int br = (r < 128) ? nbrow0 + r : nbrow1 + r - 128;
      noffB[i] = br * nldb + c * 8;
    }
  }
  const int ldA = wave * 8 * MI * 64, ldB = ABYTES + wave * 32 * 64;
#define DMA_NEXT(kt, sofs) do { \
    _Pragma("unroll") for (int i_ = 0; i_ < NAI; ++i_) __builtin_amdgcn_global_load_lds((const unsigned*)(nA + noffA[i_] + (kt) * 32), (LAS unsigned*)(lds + (sofs) + ldA + i_ * 1024), 16, 0, 0); \
    _Pragma("unroll") for (int i_ = 0; i_ < 2; ++i_) __builtin_amdgcn_global_load_lds((const unsigned*)(nB + noffB[i_] + (kt) * 32), (LAS unsigned*)(lds + (sofs) + ldB + i_ * 1024), 16, 0, 0); } while (0)
#define DMA_TILE(kt, sofs) do { \
    _Pragma("unroll") for (int i_ = 0; i_ < NAI; ++i_) __builtin_amdgcn_global_load_lds((const unsigned*)(A + offA[i_] + (kt) * 32), (LAS unsigned*)(lds + (sofs) + ldA + i_ * 1024), 16, 0, 0); \
    _Pragma("unroll") for (int i_ = 0; i_ < 2; ++i_) __builtin_amdgcn_global_load_lds((const unsigned*)(B + offB[i_] + (kt) * 32), (LAS unsigned*)(lds + (sofs) + ldB + i_ * 1024), 16, 0, 0); } while (0)
  const int nk = K >> 5;
  if (!(CHAIN && has_prev)) {
    DMA_TILE(0, 0);
    DMA_TILE(1, STAGE);
    DMA_TILE(2, 2 * STAGE);
    if constexpr (MI == 4) WAITBAR(8); else WAITBAR(6);
  }
  const unsigned ldsbase = (unsigned)(size_t)lds;
  const int swz = (l32 >> 2) & 3;
  const int arow = (wr * 32 * MI + l32) * 64, brow = ABYTES + (wc * 64 + l32) * 64;
  const int ck0 = (g ^ swz) * 16, ck1 = ((2 + g) ^ swz) * 16;
#define FRAG_READ(AF, BF, aaddr, baddr) do { \
    _Pragma("unroll") for (int ni_ = 0; ni_ < 2; ++ni_) asm volatile("ds_read_b128 %0, %1 offset:%2" : "=&v"(BF[ni_]) : "v"(baddr), "n"(ni_ * 2048) : "memory"); \
    _Pragma("unroll") for (int mi_ = 0; mi_ < MI; ++mi_) asm volatile("ds_read_b128 %0, %1 offset:%2" : "=&v"(AF[mi_]) : "v"(aaddr), "n"(mi_ * 2048) : "memory"); } while (0)
#define PLAINBAR() asm volatile("s_barrier" ::: "memory")
  bf16x8 af0[MI], bf0[2], af1[MI], bf1[2];
  if (wr == 1) PLAINBAR();
  int cur = 0;
  for (int t = 0; t < nk; ++t) {
    FRAG_READ(af0, bf0, ldsbase + (unsigned)(cur + arow + ck0), ldsbase + (unsigned)(cur + brow + ck0));
    FRAG_READ(af1, bf1, ldsbase + (unsigned)(cur + arow + ck1), ldsbase + (unsigned)(cur + brow + ck1));
    if (t + 2 < nk || has_next) { if constexpr (MI == 4) WAITBAR(4); else WAITBAR(3); }
    else WAITBAR(0);
    int nx = cur + 3 * STAGE; if (nx >= 4 * STAGE) nx -= 4 * STAGE;
    __builtin_amdgcn_sched_barrier(0);
#pragma unroll
    for (int mi = 0; mi < MI; ++mi)
#pragma unroll
      for (int ni = 0; ni < 2; ++ni) acc[mi][ni] = mfma(af0[mi], bf0[ni], acc[mi][ni]);
    __builtin_amdgcn_sched_barrier(0);
    if (t + 3 < nk) DMA_TILE(t + 3, nx);
    else if (has_next) DMA_NEXT(t + 3 - nk, nx);
    __builtin_amdgcn_sched_barrier(0);
#pragma unroll
    for (int mi = 0; mi < MI; ++mi)
#pragma unroll
      for (int ni = 0; ni < 2; ++ni) acc[mi][ni] = mfma(af1[mi], bf1[ni], acc[mi][ni]);
    __builtin_amdgcn_sched_barrier(0);
    PLAINBAR();
    cur += STAGE; if (cur >= 4 * STAGE) cur -= 4 * STAGE;
  }
  if (wr == 0) PLAINBAR();
#undef FRAG_READ
#undef PLAINBAR
#undef DMA_TILE
#undef DMA_NEXT
}

template <int MI>
DEVI void zero_acc(f32x16 (&acc)[MI][2]) {
#pragma unroll
  for (int a = 0; a < MI; ++a)
#pragma unroll
    for (int b = 0; b < 2; ++b)
#pragma unroll
      for (int r = 0; r < 16; ++r) acc[a][b][r] = 0.f;
}

DEVI void acc_to_lds(const f32x16 (&acc)[2][2], lchar* lds) {
  const int tid = otid(), lane = tid & 63, wave = tid >> 6, wr = wave >> 2, wc = wave & 3, l32 = lane & 31, g = lane >> 5;
  LAS float* Cs = (LAS float*)lds;
#pragma unroll
  for (int mi = 0; mi < 2; ++mi)
#pragma unroll
    for (int ni = 0; ni < 2; ++ni)
#pragma unroll
      for (int r = 0; r < 16; ++r) Cs[(wr * 64 + mi * 32 + crow(r, g)) * CP + wc * 64 + ni * 32 + l32] = acc[mi][ni][r];
}
DEVI void acc_to_lds_half(const f32x16 (&acc)[4][2], lchar* lds, int hf, int rowofs) {
  const int tid = otid(), lane = tid & 63, wave = __builtin_amdgcn_readfirstlane(tid >> 6), wr = wave >> 2, wc = wave & 3, l32 = lane & 31, g = lane >> 5;
  LAS float* Cs = (LAS float*)lds;
  if (wr == hf) {
#pragma unroll
    for (int mi = 0; mi < 4; ++mi)
#pragma unroll
      for (int ni = 0; ni < 2; ++ni)
#pragma unroll
        for (int r = 0; r < 16; ++r) Cs[(rowofs + mi * 32 + crow(r, g)) * CP + wc * 64 + ni * 32 + l32] = acc[mi][ni][r];
  }
}

DEVI int xsched_idx(int i) { const int ns = gridDim.x >> 3; return (i * 8 + (int)(blockIdx.x & 7)) * ns + (int)(blockIdx.x >> 3); }
DEVI bool gemm_tile(int idx, int MT, int NT, int& mt, int& nt) { const int mg = idx / (4 * NT), rem = idx - mg * 4 * NT; nt = rem >> 2; mt = mg * 4 + (rem & 3); return mt < MT; }

DEVI void transpose_item(const float* __restrict__ W, int K, int N, bf16* __restrict__ Wt, int item, lchar* lds) {
  const int nnb = N >> 6, kb = item / nnb, nb = item - kb * nnb, tid = otid();
  LAS float* t = (LAS float*)lds;
  __syncthreads();
#pragma unroll
  for (int i = 0; i < 8; ++i) { const int k = (tid >> 6) + 8 * i, n = tid & 63; t[k * 65 + n] = W[(size_t)(kb * 64 + k) * N + nb * 64 + n]; }
  __syncthreads();
  {
    const int n = tid >> 3, kc = tid & 7;
    float v[8];
#pragma unroll
    for (int j = 0; j < 8; ++j) v[j] = t[(kc * 8 + j) * 65 + n];
    u32x4 o; o.x = cvtpk(v[0], v[1]); o.y = cvtpk(v[2], v[3]); o.z = cvtpk(v[4], v[5]); o.w = cvtpk(v[6], v[7]);
    *(u32x4*)(Wt + (size_t)(nb * 64 + n) * K + kb * 64 + kc * 8) = o;
  }
}

DEVI void phase_weights(const Params& p, lchar* lds) {
  constexpr int I_IN = 16 * 108, I_B = 4 * 16, I_OUT = 16 * 16, I_UP = 16 * 88, I_DN = 44 * 16;
  constexpr int T_IN = 2 * I_IN, T_B = 8 * I_B, T_OUT = 2 * I_OUT, T_UP = 2 * I_UP, T_DN = 2 * I_DN;
  constexpr int TOTAL = T_IN + T_B + T_OUT + T_UP + T_DN;
  for (int it = blockIdx.x; it < TOTAL; it += gridDim.x) {
    int r = it;
    if (r < T_IN) { const int l = r / I_IN; transpose_item(p.w_in + (size_t)l * DM * INC, DM, INC, (bf16*)(p.ws + WS_WIN) + (size_t)l * INC * DM, r - l * I_IN, lds); continue; }
    r -= T_IN;
    if (r < T_B) { const int lb = r / I_B; transpose_item(p.w_branch + (size_t)lb * 256 * DM, 256, DM, (bf16*)(p.ws + WS_WB) + (size_t)lb * DM * 256, r - lb * I_B, lds); continue; }
    r -= T_B;
    if (r < T_OUT) { const int l = r / I_OUT; transpose_item(p.w_out + (size_t)l * DM * DM, DM, DM, (bf16*)(p.ws + WS_WOUT) + (size_t)l * DM * DM, r - l * I_OUT, lds); continue; }
    r -= T_OUT;
    if (r < T_UP) { const int l = r / I_UP; transpose_item(p.w_up + (size_t)l * DM * NUP, DM, NUP, (bf16*)(p.ws + WS_WUP) + (size_t)l * NUP * DM, r - l * I_UP, lds); continue; }
    r -= T_UP;
    { const int l = r / I_DN; transpose_item(p.w_down + (size_t)l * DFF * DM, DFF, DM, (bf16*)(p.ws + WS_WDN) + (size_t)l * DM * DFF, r - l * I_DN, lds); }
  }
}

DEVI void phase_norm(const Params& p, int mode, const float* __restrict__ gain) {
  const int lane = otid() & 63, gw = blockIdx.x * 8 + (otid() >> 6), ngw = gridDim.x * 8;
  bf16* H = (bf16*)(p.ws + WS_H);
  f32x4 gg[4];
#pragma unroll
  for (int j = 0; j < 4; ++j) gg[j] = ((const f32x4*)gain)[lane + 64 * j];
  for (int row0 = gw; row0 < MTOK / 2; row0 += ngw) {
    f32x4 v[2][4]; float ss[2];
#pragma unroll
    for (int u = 0; u < 2; ++u) {
      const int row = row0 + u * (MTOK / 2);
      const float* src = (mode == 0) ? (row < 2 * SEQ ? p.xp + (size_t)row * DM : p.xs + (size_t)(row - 2 * SEQ) * DM) : p.out + (size_t)row * DM;
#pragma unroll
      for (int j = 0; j < 4; ++j) v[u][j] = ((const f32x4*)src)[lane + 64 * j];
    }
#pragma unroll
    for (int u = 0; u < 2; ++u) {
      float s = 0.f;
#pragma unroll
      for (int j = 0; j < 4; ++j) s += (v[u][j].x * v[u][j].x + v[u][j].y * v[u][j].y) + (v[u][j].z * v[u][j].z + v[u][j].w * v[u][j].w);
      ss[u] = wave_sum(s);
    }
#pragma unroll
    for (int u = 0; u < 2; ++u) {
      const int row = row0 + u * (MTOK / 2);
      const float rstd = 1.0f / sqrtf(ss[u] * (1.0f / DM) + EPS);
      float* orow = p.out + (size_t)row * DM;
#pragma unroll
      for (int j = 0; j < 4; ++j) {
        if (mode == 0) ((f32x4*)orow)[lane + 64 * j] = v[u][j];
        const f32x4 y = v[u][j] * rstd * gg[j];
        if (mode == 2) ((f32x4*)orow)[lane + 64 * j] = y;
        else { u32x2 w; w.x = cvtpk(y.x, y.y); w.y = cvtpk(y.z, y.w); ((u32x2*)(H + (size_t)row * DM))[lane + 64 * j] = w; }
      }
    }
  }
}

DEVI void rot(float& a, float& b, double t) {
  const float rv = (float)(t - __builtin_rint(t));
  const float cs = __builtin_amdgcn_cosf(rv), sn = __builtin_amdgcn_sinf(rv);
  const float x1 = a, x2 = b; a = x1 * cs - x2 * sn; b = x2 * cs + x1 * sn;
}

DEVI void phase_qkv(const Params& p, int layer, lchar* lds) {
  const bf16* H = (const bf16*)(p.ws + WS_H);
  const bf16* Wt = (const bf16*)(p.ws + WS_WIN) + (size_t)layer * INC * DM;
  bf16* QKV = (bf16*)(p.ws + WS_QKV);
  const int tid = otid();
  constexpr int NT = 11, MT = MTOK / 256, TILES = MT * NT;
  for (int i = 0;; ++i) {
    const int idx = xsched_idx(i); if (idx >= TILES) break;
    int mt, nt; gemm_tile(idx, MT, NT, mt, nt);
    const int n0 = nt * 256;
    f32x16 acc[4][2]; zero_acc<4>(acc);
    gemm_dma<4>(acc, lds, H, DM, mt * 256, 0, MTOK - 1, Wt, DM, n0, n0 + 128, DM);
    {
      const int lane = tid & 63, wave = __builtin_amdgcn_readfirstlane(tid >> 6), wr = wave >> 2, wc = wave & 3, l32 = lane & 31, g = lane >> 5;
      LAS float* Wp = (LAS float*)(lds + wave * 17408);
      const int G = nt * 4 + wc;
      const float qs = 0.125f * LOG2E;
      const bool isD = (G >= 36 && G < 42);
#pragma unroll
      for (int c2 = 0; c2 < 2; ++c2) {
#pragma unroll
        for (int mi = 0; mi < 2; ++mi)
#pragma unroll
          for (int ni = 0; ni < 2; ++ni)
#pragma unroll
            for (int r = 0; r < 16; ++r) Wp[(mi * 32 + crow(r, g)) * 68 + ni * 32 + l32] = acc[2 * c2 + mi][ni][r];
        asm volatile("s_waitcnt lgkmcnt(0)" ::: "memory");
        const int grow = mt * 256 + wr * 128 + c2 * 64 + lane, pos = grow & (SEQ - 1);
        const LAS float* rowp = Wp + lane * 68;
        float rstd = 1.f;
        if (isD) {
          float ss = 0.f;
#pragma unroll
          for (int i = 0; i < 16; ++i) { const f32x4 t = *(const LAS f32x4*)(rowp + 4 * i); ss += (t.x * t.x + t.y * t.y) + (t.z * t.z + t.w * t.w); }
          rstd = 1.0f / sqrtf(ss * (1.0f / 64.0f) + EPS);
        }
        bf16* dst = QKV + (size_t)grow * NQKV + G * 64;
#pragma unroll 1
        for (int hh = 0; hh < 2; ++hh) {
          float v[32];
#pragma unroll
          for (int i = 0; i < 8; ++i) { const f32x4 t = *(const LAS f32x4*)(rowp + hh * 32 + 4 * i); v[4 * i] = t.x; v[4 * i + 1] = t.y; v[4 * i + 2] = t.z; v[4 * i + 3] = t.w; }
          float sc = 1.f;
          if (G < 8) {
#pragma unroll
            for (int i = 0; i < 4; ++i) rot(v[i], v[4 + i], (double)pos * p.invA[i]);
            if (G < 4) sc = 0.17677669529663687f * LOG2E;
          } else if (G >= 12 && G < 16) { sc = qs;
          } else if (G >= 24 && G < 32) {
            if (hh == 0) {
#pragma unroll
              for (int i = 0; i < 8; ++i) rot(v[i], v[8 + i], (double)pos * p.invC[i]);
            }
            if (G < 28) sc = qs;
          } else if (isD) {
            const float* gq = p.qk_norm + layer * 128 + (G < 40 ? 0 : 64) + hh * 32;
#pragma unroll
            for (int i = 0; i < 32; ++i) v[i] = v[i] * rstd * gq[i];
            const int pa = hh == 0 ? (pos >> 6) : (pos & 63);
#pragma unroll
            for (int i = 0; i < 16; ++i) rot(v[i], v[16 + i], (double)pa * p.invD[i]);
            if (G < 40) sc = qs;
          }
#pragma unroll
          for (int i = 0; i < 4; ++i) {
            u32x4 o; o.x = cvtpk(v[8 * i] * sc, v[8 * i + 1] * sc); o.y = cvtpk(v[8 * i + 2] * sc, v[8 * i + 3] * sc);
            o.z = cvtpk(v[8 * i + 4] * sc, v[8 * i + 5] * sc); o.w = cvtpk(v[8 * i + 6] * sc, v[8 * i + 7] * sc);
            ((u32x4*)(dst + hh * 32))[i] = o;
          }
        }
        asm volatile("s_waitcnt lgkmcnt(0)" ::: "memory");
      }
    }
    __syncthreads();
  }
}

struct FState { float m; bool init; f32x16 negm; f32x16 o[2]; f32x16 ls; };
DEVI void fstate_init(FState& st) {
  st.m = 0.f; st.init = false;
#pragma unroll
  for (int r = 0; r < 16; ++r) { st.negm[r] = 0.f; st.o[0][r] = 0.f; st.o[1][r] = 0.f; st.ls[r] = 0.f; }
}
template <int NKH>
DEVI void flash_update(f32x16 (&s)[NKH], FState& st, const lchar* vb, int dhs, int lane) {
  float mx = s[0][0];
#pragma unroll
  for (int kh = 0; kh < NKH; ++kh)
#pragma unroll
    for (int r = 0; r < 16; ++r) mx = fmaxf(mx, s[kh][r]);
  mx = fmaxf(mx, __shfl_xor(mx, 32));
  const bool fin = mx > -1e30f;
  const bool upd = (mx > 8.0f) || (!st.init && fin);
  st.init = st.init || fin;
  if (__any(upd)) {
    const float d = upd ? mx : 0.f;
    st.m += d;
    const float alpha = ex2(-d);
#pragma unroll
    for (int dh = 0; dh < 2; ++dh)
#pragma unroll
      for (int r = 0; r < 16; ++r) st.o[dh][r] *= alpha;
#pragma unroll
    for (int r = 0; r < 16; ++r) st.ls[r] *= alpha;
#pragma unroll
    for (int kh = 0; kh < NKH; ++kh)
#pragma unroll
      for (int r = 0; r < 16; ++r) s[kh][r] -= d;
    const float nm = -st.m;
#pragma unroll
    for (int r = 0; r < 16; ++r) st.negm[r] = nm;
  }
#pragma unroll
  for (int kh = 0; kh < NKH; ++kh)
#pragma unroll
    for (int r = 0; r < 16; ++r) s[kh][r] = ex2(s[kh][r]);
  const int g = lane >> 5;
  const lchar* vp = vb + (4 * g + ((lane & 15) >> 2)) * 64 + ((lane >> 4) & 1) * 32 + (lane & 3) * 8;
  const bf16x8 ones = {0x3f80, 0x3f80, 0x3f80, 0x3f80, 0x3f80, 0x3f80, 0x3f80, 0x3f80};
#pragma unroll
  for (int kh = 0; kh < NKH; ++kh)
#pragma unroll
    for (int j = 0; j < 2; ++j) {
      u32x4 pw; pw.x = cvtpk(s[kh][8 * j], s[kh][8 * j + 1]); pw.y = cvtpk(s[kh][8 * j + 2], s[kh][8 * j + 3]);
      pw.z = cvtpk(s[kh][8 * j + 4], s[kh][8 * j + 5]); pw.w = cvtpk(s[kh][8 * j + 6], s[kh][8 * j + 7]);
      const bf16x8 pb = __builtin_bit_cast(bf16x8, pw);
#pragma unroll
      for (int dh = 0; dh < 2; ++dh) {
        const s16x4 lo = trread(vp + dh * dhs + (kh * 32 + 16 * j) * 64), hi = trread(vp + dh * dhs + (kh * 32 + 16 * j + 8) * 64);
        const bf16x8 a = {lo[0], lo[1], lo[2], lo[3], hi[0], hi[1], hi[2], hi[3]};
        st.o[dh] = mfma(a, pb, st.o[dh]);
      }
      st.ls = mfma(ones, pb, st.ls);
    }
}

DEVI void write_o(const f32x16 (&o)[2], float sc, bf16* dst, int g) {
#pragma unroll
  for (int dh = 0; dh < 2; ++dh)
#pragma unroll
    for (int r4 = 0; r4 < 4; ++r4) {
      u32x2 w; w.x = cvtpk(o[dh][4 * r4] * sc, o[dh][4 * r4 + 1] * sc); w.y = cvtpk(o[dh][4 * r4 + 2] * sc, o[dh][4 * r4 + 3] * sc);
      *(u32x2*)(dst + 32 * dh + 8 * r4 + 4 * g) = w;
    }
}

constexpr int AT_BUF = 17408, AT_V = 9216;

struct KVRegs { u32x4 k, v; };
DEVI void kv_load(KVRegs& r, const bf16* __restrict__ Kp, const bf16* __restrict__ Vp, int tok0, int tid) {
  const int row = tid >> 3, ch = tid & 7;
  r.k = *(const u32x4*)(Kp + (size_t)(tok0 + row) * NQKV + ch * 8);
  r.v = *(const u32x4*)(Vp + (size_t)(tok0 + row) * NQKV + ch * 8);
}
DEVI void kv_store(const KVRegs& r, lchar* buf, int tid) {
  const int row = tid >> 3, ch = tid & 7;
  *(LAS u32x4*)(buf + row * 144 + ch * 16) = r.k;
  *(LAS u32x4*)(buf + AT_V + (ch >> 2) * 4096 + row * 64 + (ch & 3) * 16) = r.v;
}

template <int NKS>
DEVI void attn_full_loop(const bf16* __restrict__ QKV, int seqbase, int tokq, int qcol, int kcol, int vcol, int kdimofs, FState& st, lchar* lds) {
  const int tid = otid(), lane = tid & 63, l32 = lane & 31, g = lane >> 5;
  bf16x8 qf[NKS];
#pragma unroll
  for (int ks = 0; ks < NKS; ++ks) qf[ks] = *(const bf16x8*)(QKV + (size_t)tokq * NQKV + qcol + 16 * ks + 8 * g);
  const bf16* Kp = QKV + kcol;
  const bf16* Vp = QKV + vcol;
  KVRegs kra[2], krb[2];
  __syncthreads();
#define KV_LOAD2(R, tok) do { kv_load(R[0], Kp, Vp, (tok), tid); kv_load(R[1], Kp, Vp, (tok) + 64, tid); } while (0)
#define KV_STORE2(R, base) do { kv_store(R[0], (base), tid); kv_store(R[1], (base) + AT_BUF, tid); } while (0)
  KV_LOAD2(kra, seqbase);
  KV_LOAD2(krb, seqbase + 128);
  KV_STORE2(kra, lds);
  __syncthreads();
  constexpr int NT2 = SEQ / 128;
#define ATT_TILE(buf) do { f32x16 s[2]; \
    _Pragma("unroll") for (int kh = 0; kh < 2; ++kh) { _Pragma("unroll") for (int ks = 0; ks < NKS; ++ks) { \
      const bf16x8 a_ = *(const LAS bf16x8*)((buf) + (kh * 32 + l32) * 144 + kdimofs + ks * 32 + g * 16); \
      s[kh] = mfma(a_, qf[ks], ks == 0 ? st.negm : s[kh]); } } \
    flash_update<2>(s, st, (buf) + AT_V, 4096, lane); } while (0)
  for (int t = 0; t < NT2; t += 2) {
    if (t + 2 < NT2) KV_LOAD2(kra, seqbase + (t + 2) * 128);
    ATT_TILE(lds);
    ATT_TILE(lds + AT_BUF);
    KV_STORE2(krb, lds + 2 * AT_BUF);
    __syncthreads();
    if (t + 3 < NT2) KV_LOAD2(krb, seqbase + (t + 3) * 128);
    ATT_TILE(lds + 2 * AT_BUF);
    ATT_TILE(lds + 3 * AT_BUF);
    if (t + 2 < NT2) KV_STORE2(kra, lds);
    __syncthreads();
  }
#undef ATT_TILE
#undef KV_LOAD2
#undef KV_STORE2
}

DEVI void attn_A(const Params& p, int layer, int it, lchar* lds) {
  const int seq = it >> 8, h = (it >> 6) & 3, qb = it & 63;
  const int tid = otid(), lane = tid & 63, wave = tid >> 6, l32 = lane & 31, g = lane >> 5;
  const int c = wave & 1, qh = wave >> 1;
  const bf16* QKV = (const bf16*)(p.ws + WS_QKV);
  bf16* O = (bf16*)(p.ws + WS_O);
  const int tokq = seq * SEQ + qb * 128 + qh * 32 + l32;
  FState st; fstate_init(st);
  attn_full_loop<2>(QKV, seq * SEQ, tokq, 64 * h + 32 * c, 256 + 64 * h, 512 + 64 * h, 64 * c, st, lds);
  f32x16 (&o)[2] = st.o;
  const float* lv = p.diff_lambda + layer * 128;
  float d1 = 0.f, d2 = 0.f;
#pragma unroll
  for (int i = 0; i < 32; ++i) { d1 += lv[i] * lv[32 + i]; d2 += lv[64 + i] * lv[96 + i]; }
  const float lam_init = p.lam_init[layer];
  const float lam = expf(d1) - expf(d2) + lam_init;
  const float lt = st.ls[0];
  const float sc = (c == 0) ? 1.0f / lt : lam / lt;
  LAS float* xb = (LAS float*)lds + qh * 2048;
  if (c == 1) {
#pragma unroll
    for (int dh = 0; dh < 2; ++dh)
#pragma unroll
      for (int r = 0; r < 16; ++r) xb[(dh * 16 + r) * 64 + lane] = o[dh][r] * sc;
  }
  __syncthreads();
  if (c == 0) {
    float ss = 0.f;
#pragma unroll
    for (int dh = 0; dh < 2; ++dh)
#pragma unroll
      for (int r = 0; r < 16; ++r) { const float x = o[dh][r] * sc - xb[(dh * 16 + r) * 64 + lane]; o[dh][r] = x; ss += x * x; }
    ss += __shfl_xor(ss, 32);
    const float rstd = (1.0f - lam_init) / sqrtf(ss * (1.0f / 64.0f) + EPS);
    const float* sg = p.diff_subln + layer * 64;
#pragma unroll
    for (int dh = 0; dh < 2; ++dh)
#pragma unroll
      for (int r = 0; r < 16; ++r) o[dh][r] *= sg[32 * dh + crow(r, g)];
    write_o(o, rstd, O + (size_t)tokq * DM + 64 * h, g);
  }
}

DEVI void attn_D(const Params& p, int it, lchar* lds) {
  const int seq = it >> 7, kv = (it >> 6) & 1, qb = it & 63;
  const int tid = otid(), lane = tid & 63, wave = tid >> 6, l32 = lane & 31, g = lane >> 5;
  const bf16* QKV = (const bf16*)(p.ws + WS_QKV);
  bf16* O = (bf16*)(p.ws + WS_O);
  const int hq = 2 * kv + (wave & 1);
  const int tokq = seq * SEQ + qb * 128 + (wave >> 1) * 32 + l32;
  FState st; fstate_init(st);
  attn_full_loop<4>(QKV, seq * SEQ, tokq, 2304 + 64 * hq, 2560 + 64 * kv, 2688 + 64 * kv, 0, st, lds);
  const float lt = st.ls[0];
  write_o(st.o, 1.0f / lt, O + (size_t)tokq * DM + 768 + 64 * hq, g);
}

constexpr int ATB_BIAS = 8 * AT_BUF;
struct KVRegs4 { u32x4 k[4], v[4]; };
DEVI void kvb_load(KVRegs4& r, const bf16* __restrict__ QKV, int tok0, int tid) {
  const int hd = tid >> 7, t7 = tid & 127;
#pragma unroll
  for (int i = 0; i < 4; ++i) {
    const int c = t7 + 128 * i, row = c >> 3, ch = c & 7;
    r.k[i] = *(const u32x4*)(QKV + (size_t)(tok0 + row) * NQKV + 1024 + 64 * hd + ch * 8);
    r.v[i] = *(const u32x4*)(QKV + (size_t)(tok0 + row) * NQKV + 1280 + 64 * hd + ch * 8);
  }
}
DEVI void kvb_store(const KVRegs4& r, lchar* lds, int bufsel, int tid) {
  const int hd = tid >> 7, t7 = tid & 127;
  lchar* buf = lds + (hd * 2 + bufsel) * AT_BUF;
#pragma unroll
  for (int i = 0; i < 4; ++i) {
    const int c = t7 + 128 * i, row = c >> 3, ch = c & 7;
    *(LAS u32x4*)(buf + row * 144 + ch * 16) = r.k[i];
    *(LAS u32x4*)(buf + AT_V + (ch >> 2) * 4096 + row * 64 + (ch & 3) * 16) = r.v[i];
  }
}
DEVI void attn_B(const Params& p, int layer, int it, lchar* lds) {
  const int seq = it >> 7, r = it & 127;
  const int tid = otid(), lane = tid & 63, wave = tid >> 6, l32 = lane & 31, g = lane >> 5;
  const int h = wave >> 1;
  const bf16* QKV = (const bf16*)(p.ws + WS_QKV);
  bf16* O = (bf16*)(p.ws + WS_O);
  const int qc = (wave & 1) * 32 + l32;
  const int tokq = seq * SEQ + r * 64 + qc;
  bf16x8 qf[4];
#pragma unroll
  for (int ks = 0; ks < 4; ++ks) qf[ks] = *(const bf16x8*)(QKV + (size_t)tokq * NQKV + 768 + 64 * h + 16 * ks + 8 * g);
  int rs = r - 4; rs = rs < 0 ? 0 : (rs > 120 ? 120 : rs);
  const int tokk = seq * SEQ + rs * 64;
  LAS float* bias = (LAS float*)(lds + ATB_BIAS) + h * 465;
  const float* rpb = p.na_rpb + (size_t)(layer * 4) * 465;
  FState st; fstate_init(st);
  int cs = qc - 8; cs = cs < 0 ? 0 : (cs > 48 ? 48 : cs);
  __syncthreads();
  for (int i = tid; i < 4 * 465; i += NTHR) ((LAS float*)(lds + ATB_BIAS))[i] = rpb[i] * LOG2E;
  for (int t = 0; t < 8; ++t) {
    __syncthreads();
    { KVRegs4 kr; kvb_load(kr, QKV, tokk + t * 64, tid); kvb_store(kr, lds, 0, tid); }
    __syncthreads();
    lchar* buf = lds + (h * 2) * AT_BUF;
    const int dr = rs + t - r + 7;
    f32x16 s[2];
#pragma unroll
    for (int kh = 0; kh < 2; ++kh) {
#pragma unroll
      for (int ks = 0; ks < 4; ++ks) {
        const bf16x8 a = *(const LAS bf16x8*)(buf + (kh * 32 + l32) * 144 + ks * 32 + g * 16);
        s[kh] = mfma(a, qf[ks], ks == 0 ? st.negm : s[kh]);
      }
#pragma unroll
      for (int rr = 0; rr < 16; ++rr) {
        const int kc = kh * 32 + crow(rr, g);
        int dc = kc - qc + 15; dc = dc < 0 ? 0 : (dc > 30 ? 30 : dc);
        const bool valid = (kc >= cs) && (kc < cs + 16);
        s[kh][rr] = valid ? s[kh][rr] + bias[dr * 31 + dc] : -INFINITY;
      }
    }
    flash_update<2>(s, st, buf + AT_V, 4096, lane);
  }
  const float lt = st.ls[0];
  write_o(st.o, 1.0f / lt, O + (size_t)tokq * DM + 256 + 64 * h, g);
}

constexpr int CW_BUF = 8704, CW_V = 4608;
struct CRegs { u32x4 k[4], v[4]; };
DEVI void c_tile_params(int tg, int& st, int& j0) {
  if (tg < 5) { st = 16; j0 = -64 + 32 * tg; }
  else if (tg < 13) { st = 4; j0 = -64 + 32 * (tg - 5); }
  else { st = 1; j0 = -64 + 32 * (tg - 13); }
}
DEVI void c_load(CRegs& r, const bf16* __restrict__ Kp, const bf16* __restrict__ Vp, int seqbase, int qp0, int tg, int lane) {
  int st, j0; c_tile_params(tg, st, j0);
#pragma unroll
  for (int i = 0; i < 4; ++i) {
    const int c = lane + 64 * i, row = c >> 3, ch = c & 7;
    int kp = qp0 + st * (j0 + row); kp = kp < 0 ? 0 : (kp > SEQ - 1 ? SEQ - 1 : kp);
    r.k[i] = *(const u32x4*)(Kp + (size_t)(seqbase + kp) * NQKV + ch * 8);
    r.v[i] = *(const u32x4*)(Vp + (size_t)(seqbase + kp) * NQKV + ch * 8);
  }
}
DEVI void c_store(const CRegs& r, lchar* wb, int lane) {
#pragma unroll
  for (int i = 0; i < 4; ++i) {
    const int c = lane + 64 * i, row = c >> 3, ch = c & 7;
    *(LAS u32x4*)(wb + row * 144 + ch * 16) = r.k[i];
    *(LAS u32x4*)(wb + CW_V + (ch >> 2) * 2048 + row * 64 + (ch & 3) * 16) = r.v[i];
  }
}
DEVI void attn_C(const Params& p, int it, lchar* lds) {
  const int seq = it >> 7, h = (it >> 5) & 3, span = (it >> 1) & 15, half = it & 1;
  const int tid = otid(), lane = tid & 63, wave = tid >> 6, l32 = lane & 31, g = lane >> 5;
  const bf16* QKV = (const bf16*)(p.ws + WS_QKV);
  bf16* O = (bf16*)(p.ws + WS_O);
  const int rho = half * 8 + wave, qp0 = span * 512 + rho;
  const int seqbase = seq * SEQ;
  const int tokq = seqbase + qp0 + 16 * l32;
  bf16x8 qf[4];
#pragma unroll
  for (int ks = 0; ks < 4; ++ks) qf[ks] = *(const bf16x8*)(QKV + (size_t)tokq * NQKV + 1536 + 64 * h + 16 * ks + 8 * g);
  const bf16* Kp = QKV + 1792 + 64 * h;
  const bf16* Vp = QKV + 2048 + 64 * h;
  lchar* wb = lds + wave * CW_BUF;
  FState fs; fstate_init(fs);
  CRegs cr;
  c_load(cr, Kp, Vp, seqbase, qp0, 0, lane);
  __syncthreads();
  for (int tg = 0; tg < 33; ++tg) {
    asm volatile("" ::: "memory");
    c_store(cr, wb, lane);
    asm volatile("s_waitcnt lgkmcnt(0)" ::: "memory");
    if (tg + 1 < 33) c_load(cr, Kp, Vp, seqbase, qp0, tg + 1, lane);
    int st, j0; c_tile_params(tg, st, j0);
    f32x16 s[1];
#pragma unroll
    for (int ks = 0; ks < 4; ++ks) {
      const bf16x8 a = *(const LAS bf16x8*)(wb + l32 * 144 + ks * 32 + g * 16);
      s[0] = mfma(a, qf[ks], ks == 0 ? fs.negm : s[0]);
    }
#pragma unroll
    for (int rr = 0; rr < 16; ++rr) {
      const int jj = j0 + crow(rr, g);
      const int kp = qp0 + st * jj;
      int dd = 16 * l32 - st * jj; dd = dd < 0 ? -dd : dd;
      const bool valid = (dd <= 64 * st) && (kp >= 0) && (kp < SEQ);
      s[0][rr] = valid ? s[0][rr] : -INFINITY;
    }
    flash_update<1>(s, fs, wb + CW_V, 2048, lane);
  }
  const float lt = fs.ls[0];
  write_o(fs.o, 1.0f / lt, O + (size_t)tokq * DM + 512 + 64 * h, g);
}

DEVI void phase_attn(const Params& p, int layer, lchar* lds) {
  constexpr int NA = NSEQ * 4 * 64, ND = NSEQ * 2 * 64, NB = NSEQ * 128, NC = NSEQ * 4 * 16 * 2;
  for (int i = 0;; ++i) {
    const int it = xsched_idx(i); if (it >= NA + ND + NB + NC) break;
    if (it < NA) attn_A(p, layer, it, lds);
    else if (it < NA + ND) attn_D(p, it - NA, lds);
    else if (it < NA + ND + NB) attn_B(p, layer, it - NA - ND, lds);
    else attn_C(p, it - NA - ND - NB, lds);
    __syncthreads();
  }
}

DEVI void phase_merge(const Params& p, int layer, lchar* lds) {
  const bf16* H = (const bf16*)(p.ws + WS_H);
  const bf16* Ob = (const bf16*)(p.ws + WS_O);
  const bf16* Wt = (const bf16*)(p.ws + WS_WIN) + (size_t)layer * INC * DM;
  const bf16* Wb = (const bf16*)(p.ws + WS_WB) + (size_t)layer * 4 * DM * 256;
  bf16* MG = (bf16*)(p.ws + WS_QKV);
  constexpr int NT = 4, MT = MTOK / 128, TILES = MT * NT;
  for (int i = 0;; ++i) {
    const int idx = xsched_idx(i); if (idx >= TILES) break;
    const int tid = otid();
    int mt, nt; gemm_tile(idx, MT, NT, mt, nt);
    const int m0 = mt * 128, n0 = nt * 256;
    unsigned mgp[2][2][8];
#pragma unroll
    for (int mi = 0; mi < 2; ++mi)
#pragma unroll
      for (int ni = 0; ni < 2; ++ni)
#pragma unroll
        for (int j = 0; j < 8; ++j) mgp[mi][ni][j] = 0u;
    for (int b = 0; b < 4; ++b) {
      f32x16 acc[2][2]; zero_acc<2>(acc);
      const int gr = NQKV + b * DM + n0;
      gemm_dma<2, true>(acc, lds, H, DM, m0, 0, MTOK - 1, Wt, DM, gr, gr + 128, DM,
                        b > 0, Ob + 256 * b, DM, Wb + (size_t)b * DM * 256, 256, n0, n0 + 128);
      unsigned sg[2][2][8];
#pragma unroll
      for (int mi = 0; mi < 2; ++mi)
#pragma unroll
        for (int ni = 0; ni < 2; ++ni)
#pragma unroll
          for (int j = 0; j < 8; ++j) {
            const float s0 = __builtin_amdgcn_rcpf(1.0f + ex2(-acc[mi][ni][2 * j] * LOG2E));
            const float s1 = __builtin_amdgcn_rcpf(1.0f + ex2(-acc[mi][ni][2 * j + 1] * LOG2E));
            sg[mi][ni][j] = cvtpk(s0, s1);
          }
      zero_acc<2>(acc);
      gemm_dma<2, true>(acc, lds, Ob + 256 * b, DM, m0, 0, MTOK - 1, Wb + (size_t)b * DM * 256, 256, n0, n0 + 128, 256,
                        true, b < 3 ? H : nullptr, DM, Wt, DM, gr + DM, gr + DM + 128);
#pragma unroll
      for (int mi = 0; mi < 2; ++mi)
#pragma unroll
        for (int ni = 0; ni < 2; ++ni)
#pragma unroll
          for (int j = 0; j < 8; ++j) {
            const unsigned w = sg[mi][ni][j], mo = mgp[mi][ni][j];
            const float lo = __uint_as_float(mo << 16) + __uint_as_float(w << 16) * acc[mi][ni][2 * j];
            const float hi = __uint_as_float(mo & 0xffff0000u) + __uint_as_float(w & 0xffff0000u) * acc[mi][ni][2 * j + 1];
            mgp[mi][ni][j] = cvtpk(lo, hi);
          }
    }
    f32x16 mg[2][2];
#pragma unroll
    for (int mi = 0; mi < 2; ++mi)
#pragma unroll
      for (int ni = 0; ni < 2; ++ni)
#pragma unroll
        for (int j = 0; j < 8; ++j) { mg[mi][ni][2 * j] = __uint_as_float(mgp[mi][ni][j] << 16); mg[mi][ni][2 * j + 1] = __uint_as_float(mgp[mi][ni][j] & 0xffff0000u); }
    acc_to_lds(mg, lds);
    __syncthreads();
    {
      const LAS float* Cs = (const LAS float*)lds;
#pragma unroll
      for (int k = 0; k < 8; ++k) {
        const int id = tid + 512 * k, row = id >> 5, ch = id & 31;
        const f32x4 a = *(const LAS f32x4*)(Cs + row * CP + ch * 8), b2 = *(const LAS f32x4*)(Cs + row * CP + ch * 8 + 4);
        u32x4 o; o.x = cvtpk(a.x, a.y); o.y = cvtpk(a.z, a.w); o.z = cvtpk(b2.x, b2.y); o.w = cvtpk(b2.z, b2.w);
        *(u32x4*)(MG + (size_t)(m0 + row) * DM + n0 + ch * 8) = o;
      }
    }
    __syncthreads();
  }
}

DEVI void phase_resid(const Params& p, float* xout, const bf16* A, int lda, const bf16* Wt, int K, lchar* lds) {
  const int tid = otid();
  constexpr int NT = 4, MT = MTOK / 256, TILES = MT * NT;
  for (int i = 0;; ++i) {
    const int idx = xsched_idx(i); if (idx >= TILES) break;
    int mt, nt; gemm_tile(idx, MT, NT, mt, nt);
    const int n0 = nt * 256;
    f32x16 acc[4][2]; zero_acc<4>(acc);
    gemm_dma<4>(acc, lds, A, lda, mt * 256, 0, MTOK - 1, Wt, K, n0, n0 + 128, K);
    for (int hf = 0; hf < 2; ++hf) {
      const int m0 = mt * 256 + hf * 128;
      acc_to_lds_half(acc, lds, hf, 0);
      __syncthreads();
      const LAS float* Cs = (const LAS float*)lds;
#pragma unroll
      for (int k = 0; k < 16; ++k) {
        const int id = tid + 512 * k, row = id >> 6, c4 = id & 63;
        const f32x4 a = *(const LAS f32x4*)(Cs + row * CP + c4 * 4);
        f32x4* xp = (f32x4*)(xout + (size_t)(m0 + row) * DM + n0 + c4 * 4);
        *xp = *xp + a;
      }
      __syncthreads();
    }
  }
}

DEVI float gelu_exact(float v) {
  const float av = fabsf(v), t = __builtin_amdgcn_rcpf(av * 0.2316418882f + 1.0f);
  float q = t * 0.5307027145f + (-0.7265760135f); q = q * t + 0.7107068705f; q = q * t + (-0.142248368f); q = q * t + 0.127414796f; q = q * t;
  const float e = ex2((v * v) * (-0.72134752044f));
  const float mm = v * (q * e);
  return v < 0.f ? mm : v - mm;
}
DEVI void phase_up(const Params& p, int layer, lchar* lds) {
  const bf16* H = (const bf16*)(p.ws + WS_H);
  const bf16* Wt = (const bf16*)(p.ws + WS_WUP) + (size_t)layer * NUP * DM;
  bf16* ACT = (bf16*)(p.ws + WS_QKV);
  const float* cw = p.conv_w + (size_t)layer * 3 * NUP;
  const float* cb = p.conv_b + (size_t)layer * NUP;
  const int tid = otid(), lane = tid & 63, wave = __builtin_amdgcn_readfirstlane(tid >> 6), wr = wave >> 2, wc = wave & 3, l32 = lane & 31, g = lane >> 5;
  constexpr int MT = 33, NT = 22, SMT = NSEQ * MT, TILES = ((SMT + 3) / 4) * 4 * NT;
  for (int i = 0;; ++i) {
    const int idx = xsched_idx(i); if (idx >= TILES) break;
    int sm, nt; if (!gemm_tile(idx, SMT, NT, sm, nt)) continue;
    const int seq = sm / MT, mt = sm - seq * MT;
    const int seqbase = seq * SEQ, p0 = 254 * mt - 1;
    f32x16 acc[4][2]; zero_acc<4>(acc);
    gemm_dma<4>(acc, lds, H, DM, seqbase + p0, seqbase, seqbase + SEQ - 1, Wt, DM, 128 * nt, DFF + 128 * nt, DM);
    for (int hf = 0; hf < 2; ++hf) {
      LAS float* Cw = (LAS float*)lds;
      acc_to_lds_half(acc, lds, hf, hf);
      if (hf == 0 && wr == 1 && g == 0) {
#pragma unroll
        for (int ni = 0; ni < 2; ++ni) Cw[128 * CP + wc * 64 + ni * 32 + l32] = acc[0][ni][0];
      }
      if (hf == 1 && wr == 0 && g == 1) {
#pragma unroll
        for (int ni = 0; ni < 2; ++ni) Cw[wc * 64 + ni * 32 + l32] = acc[3][ni][15];
      }
      __syncthreads();
      const LAS float* Cs = (const LAS float*)lds;
#pragma unroll 1
      for (int k = 0; k < 4; ++k) {
        const int id = tid + 512 * k, lr = 1 + (id >> 4), ch = id & 15, pp = p0 + 127 * hf + lr;
        if (lr <= 127 && pp < SEQ) {
          const int c0 = 128 * nt + ch * 8;
          const float wp = pp > 0 ? 1.f : 0.f, wn = pp < SEQ - 1 ? 1.f : 0.f;
#pragma unroll 1
          for (int hh = 0; hh < 2; ++hh) {
            const f32x4 um = *(const LAS f32x4*)(Cs + (lr - 1) * CP + ch * 8 + 4 * hh), uc = *(const LAS f32x4*)(Cs + lr * CP + ch * 8 + 4 * hh),
                        un = *(const LAS f32x4*)(Cs + (lr + 1) * CP + ch * 8 + 4 * hh);
            const f32x4 w0 = *(const f32x4*)(cw + c0 + 4 * hh), w1 = *(const f32x4*)(cw + NUP + c0 + 4 * hh), w2 = *(const f32x4*)(cw + 2 * NUP + c0 + 4 * hh), bb = *(const f32x4*)(cb + c0 + 4 * hh);
            const f32x4 val = um * w0 * wp + uc * w1 + un * w2 * wn + bb;
            const f32x4 gm = *(const LAS f32x4*)(Cs + (lr - 1) * CP + 128 + ch * 8 + 4 * hh), gc = *(const LAS f32x4*)(Cs + lr * CP + 128 + ch * 8 + 4 * hh),
                        gn = *(const LAS f32x4*)(Cs + (lr + 1) * CP + 128 + ch * 8 + 4 * hh);
            const f32x4 v0 = *(const f32x4*)(cw + DFF + c0 + 4 * hh), v1 = *(const f32x4*)(cw + NUP + DFF + c0 + 4 * hh), v2 = *(const f32x4*)(cw + 2 * NUP + DFF + c0 + 4 * hh), vb = *(const f32x4*)(cb + DFF + c0 + 4 * hh);
            const f32x4 gt = gm * v0 * wp + gc * v1 + gn * v2 * wn + vb;
            u32x2 o; o.x = cvtpk(gelu_exact(gt.x) * val.x, gelu_exact(gt.y) * val.y); o.y = cvtpk(gelu_exact(gt.z) * val.z, gelu_exact(gt.w) * val.w);
            *(u32x2*)(ACT + (size_t)(seqbase + pp) * DFF + c0 + 4 * hh) = o;
          }
        }
      }
      __syncthreads();
    }
  }
}

#define XB_TMO      128
#define XB_XCNT(j)  (256  + 64 * (j))
#define XB_XSUB(j)  (1280 + 64 * (j))
#define XB_XGEN(j)  (2304 + 64 * (j))
#define XB_TOP      3328
#define XB_TOPGEN   3392
#define XCD_BAR_WORDS 3456
#define XB_SPIN_CAP (1u << 22)
DEVI unsigned xb_ld(unsigned* p)              { return __hip_atomic_load(p, __ATOMIC_RELAXED, __HIP_MEMORY_SCOPE_AGENT); }
DEVI unsigned xb_add(unsigned* p, unsigned v) { return __hip_atomic_fetch_add(p, v, __ATOMIC_RELAXED, __HIP_MEMORY_SCOPE_AGENT); }
DEVI unsigned xb_xcc_id() { return (unsigned)__builtin_amdgcn_s_getreg((3 << 11) | 20) & 0xFu; }
#define XB_SPIN(cond, bar) do { unsigned _sp = 0; while (cond) { __builtin_amdgcn_s_sleep(1); \
    if ((++_sp & 255u) == 0u) { if (xb_ld(&(bar)[XB_TMO])) break; if (_sp > XB_SPIN_CAP) { atomicAdd(&(bar)[XB_TMO], 1u); break; } } } } while (0)
struct XcdBarrier { unsigned* bar; unsigned x; volatile LAS unsigned* st; };
DEVI XcdBarrier xcd_barrier_post(unsigned* bar, volatile LAS unsigned* st) {
  XcdBarrier b; b.bar = bar; b.x = xb_xcc_id(); b.st = st;
  if (threadIdx.x == 0) (void)xb_add(&bar[XB_XCNT(b.x)], 1u);
  return b;
}
DEVI void xcd_barrier_complete(unsigned* bar, unsigned x, unsigned& nloc, unsigned& nx) {
  const unsigned G = gridDim.x * gridDim.y * gridDim.z;
  unsigned sum, cnt, mine, sp = 0u;
  for (;;) {
    sum = 0u; cnt = 0u; mine = 0u;
#pragma unroll
    for (unsigned j = 0; j < 16; ++j) { const unsigned c = xb_ld(&bar[XB_XCNT(j)]); sum += c; cnt += (c > 0u) ? 1u : 0u; mine = (j == x) ? c : mine; }
    if (sum == G) break;
    __builtin_amdgcn_s_sleep(1);
    if ((++sp & 255u) == 0u) { if (xb_ld(&bar[XB_TMO])) break; if (sp > XB_SPIN_CAP) { atomicAdd(&bar[XB_TMO], 1u); break; } }
  }
  nloc = mine > 0u ? mine : 1u; nx = cnt > 0u ? cnt : 1u;
}
DEVI void xcd_barrier(const XcdBarrier& b) {
  asm volatile("s_waitcnt vmcnt(0)" ::: "memory");
  __syncthreads();
  if (threadIdx.x == 0) {
    unsigned* bar = b.bar;
    __builtin_amdgcn_s_waitcnt(0);
    unsigned nloc = b.st[0], nx = b.st[1];
    if (nloc == 0u) { xcd_barrier_complete(bar, b.x, nloc, nx); b.st[0] = nloc; b.st[1] = nx; }
    const unsigned old = xb_add(&bar[XB_XSUB(b.x)], 1u);
    const unsigned gen = old / nloc;
    if (old + 1u == (gen + 1u) * nloc) {
      __builtin_amdgcn_fence(__ATOMIC_RELEASE, "agent");
      asm volatile("s_waitcnt vmcnt(0)" ::: "memory");
      const unsigned og = xb_add(&bar[XB_TOP], 1u);
      const unsigned tg = og / nx;
      if (og + 1u == (tg + 1u) * nx) xb_add(&bar[XB_TOPGEN], 1u);
      else XB_SPIN(xb_ld(&bar[XB_TOPGEN]) == tg, bar);
      __builtin_amdgcn_fence(__ATOMIC_ACQUIRE, "agent");
      xb_add(&bar[XB_XGEN(b.x)], 1u);
      asm volatile("s_waitcnt vmcnt(0)" ::: "memory");
    } else {
      XB_SPIN(xb_ld(&bar[XB_XGEN(b.x)]) == gen, bar);
      __builtin_amdgcn_fence(__ATOMIC_ACQUIRE, "agent");
      asm volatile("s_waitcnt vmcnt(0)" ::: "memory");
    }
  }
  __syncthreads();
}

constexpr int NPHASE = 17;
__global__ void __launch_bounds__(NTHR, 2) fwd_kernel(Params p) {
  __shared__ __attribute__((aligned(16))) char lds_raw[LDS_BYTES];
  __shared__ unsigned xb_state[2];
  lchar* lds = (lchar*)lds_raw;
  if (threadIdx.x < 2) xb_state[threadIdx.x] = 0u;
  __syncthreads();
  if (p.nseq == 12345) cg::this_grid().sync();
  const XcdBarrier xbar = xcd_barrier_post((unsigned*)(p.ws + WS_CTL), (volatile LAS unsigned*)xb_state);
#define GRID_SYNC() xcd_barrier(xbar)
  for (int i = 0; i < p.nseq; ++i) {
    if (i) GRID_SYNC();
    const int ph = (int)(((i < 12) ? (p.seq0 >> (5 * i)) : (p.seq1 >> (5 * (i - 12)))) & 31ull);
    if (ph == 0) { phase_weights(p, lds); phase_norm(p, 0, p.norm_attn); continue; }
    const int layer = (ph - 1) >> 3, sub = (ph - 1) & 7;
    switch (sub) {
      case 0: phase_qkv(p, layer, lds); break;
      case 1: phase_attn(p, layer, lds); break;
      case 2: phase_merge(p, layer, lds); break;
      case 3: phase_resid(p, p.out, (const bf16*)(p.ws + WS_QKV), DM, (const bf16*)(p.ws + WS_WOUT) + (size_t)layer * DM * DM, DM, lds); break;
      case 4: phase_norm(p, 1, p.norm_mlp + layer * DM); break;
      case 5: phase_up(p, layer, lds); break;
      case 6: phase_resid(p, p.out, (const bf16*)(p.ws + WS_QKV), DFF, (const bf16*)(p.ws + WS_WDN) + (size_t)layer * DM * DFF, DFF, lds); break;
      default: if (layer == 0) phase_norm(p, 1, p.norm_attn + DM); else phase_norm(p, 2, p.norm_final); break;
    }
  }
}

extern "C" void kernel_launch(void* const* d_in, const int* in_sizes, int n_in, void* d_out, int out_size, void* d_ws, size_t ws_size, hipStream_t stream) {
  static int grid = 0;
  if (grid == 0) {
    if (n_in != 16 || out_size != MTOK * DM || ws_size < WS_END) { fprintf(stderr, "kernel_launch: unexpected shapes (n_in %d out %d ws %zu need %zu)\n", n_in, out_size, ws_size, (size_t)WS_END); grid = -1; return; }
    int dev = 0, cus = 0, per_cu = 0;
    hipGetDevice(&dev);
    hipDeviceGetAttribute(&cus, hipDeviceAttributeMultiprocessorCount, dev);
    hipOccupancyMaxActiveBlocksPerMultiprocessor(&per_cu, fwd_kernel, NTHR, 0);
    if (per_cu < 1) per_cu = 1;
    if (per_cu > 1) per_cu = 1;
    grid = (cus * per_cu) & ~7;
    if (grid < 8) grid = -1;
  }
  if (grid < 0) return;
  Params p{};
  p.xp = (const float*)d_in[0]; p.xs = (const float*)d_in[1]; p.norm_attn = (const float*)d_in[2]; p.w_in = (const float*)d_in[3];
  p.diff_lambda = (const float*)d_in[4]; p.diff_subln = (const float*)d_in[5]; p.na_rpb = (const float*)d_in[6]; p.qk_norm = (const float*)d_in[7];
  p.w_branch = (const float*)d_in[8]; p.w_out = (const float*)d_in[9]; p.norm_mlp = (const float*)d_in[10]; p.w_up = (const float*)d_in[11];
  p.conv_w = (const float*)d_in[12]; p.conv_b = (const float*)d_in[13]; p.w_down = (const float*)d_in[14]; p.norm_final = (const float*)d_in[15];
  p.out = (float*)d_out; p.ws = (char*)d_ws;
  const double TWO_PI = 6.283185307179586476925286766559;
  for (int i = 0; i < 4; ++i) p.invA[i] = std::exp(-std::log(500000.0) * i / 4.0) / TWO_PI;
  for (int i = 0; i < 8; ++i) p.invC[i] = std::exp(-std::log(500000.0) * i / 8.0) / TWO_PI;
  for (int i = 0; i < 16; ++i) p.invD[i] = std::exp(-std::log(10000.0) * i / 16.0) / TWO_PI;
  for (int l = 0; l < 2; ++l) p.lam_init[l] = (float)(0.8 - 0.6 * std::exp(-0.3 * l));
  if (hipMemsetAsync((char*)d_ws + WS_CTL, 0, CTL_BYTES, stream) != hipSuccess) { fprintf(stderr, "kernel_launch: memset of barrier words failed\n"); return; }
  int codes[24]; int n = 0;
  for (int ph = 0; ph < NPHASE; ++ph) { codes[n++] = ph; if (ph > 0 && ((PROBE_DUP >> ((ph - 1) & 7)) & 1)) codes[n++] = ph; }
  p.nseq = n; p.seq0 = 0; p.seq1 = 0;
  for (int i = 0; i < n; ++i) { if (i < 12) p.seq0 |= (unsigned long long)codes[i] << (5 * i); else p.seq1 |= (unsigned long long)codes[i] << (5 * (i - 12)); }
  void* args[] = {&p};
  hipError_t e = hipLaunchCooperativeKernel((void*)fwd_kernel, dim3(grid), dim3(NTHR), args, 0, stream);
  if (e != hipSuccess) fprintf(stderr, "cooperative launch failed: %s (grid %d)\n", hipGetErrorString(e), grid);
}
```

```cpp
#include <hip/hip_runtime.h>
#include <hip/hip_cooperative_groups.h>
#include <cstdio>
#include <cmath>
namespace cg = cooperative_groups;

#ifndef MEGA
#define MEGA 1
#endif

#ifndef PROBE_DUP
#define PROBE_DUP 0
#endif
#define DEVI __device__ __forceinline__
#define LAS __attribute__((address_space(3)))
typedef unsigned short bf16;
typedef short bf16x8 __attribute__((ext_vector_type(8)));
typedef short s16x4 __attribute__((ext_vector_type(4)));
typedef float f32x16 __attribute__((ext_vector_type(16)));
typedef float f32x4 __attribute__((ext_vector_type(4)));
typedef float f32x2_t __attribute__((ext_vector_type(2)));
typedef __bf16 bf16x2_t __attribute__((ext_vector_type(2)));
typedef unsigned u32x4 __attribute__((ext_vector_type(4)));
typedef unsigned u32x2 __attribute__((ext_vector_type(2)));
typedef LAS char lchar;

constexpr int DM = 1024, SEQ = 8192, NSEQ = 10, MTOK = NSEQ * SEQ, NQKV = 2816, INC = 6912, DFF = 2816, NUP = 5632;
constexpr float LOG2E = 1.4426950408889634f;
constexpr float EPS = 1e-6f;
constexpr int NTHR = 512;
constexpr int LDS_BYTES = 147456;
constexpr int CP = 260;

constexpr size_t SZ_WIN = (size_t)2 * INC * DM * 2, SZ_WB = (size_t)2 * 4 * DM * 256 * 2, SZ_WOUT = (size_t)2 * DM * DM * 2,
                 SZ_WUP = (size_t)2 * NUP * DM * 2, SZ_WDN = (size_t)2 * DM * DFF * 2;
constexpr size_t WS_WIN = 0, WS_WB = WS_WIN + SZ_WIN, WS_WOUT = WS_WB + SZ_WB, WS_WUP = WS_WOUT + SZ_WOUT, WS_WDN = WS_WUP + SZ_WUP;
constexpr size_t WS_H = WS_WDN + SZ_WDN;
constexpr size_t WS_O = WS_H + (size_t)MTOK * DM * 2;
constexpr size_t WS_QKV = WS_O + (size_t)MTOK * DM * 2;
constexpr size_t WS_CTL = WS_QKV + (size_t)MTOK * NQKV * 2;
constexpr size_t CTL_BYTES = 16384;
constexpr size_t WS_END = WS_CTL + CTL_BYTES;

struct Params {
  const float *xp, *xs, *norm_attn, *w_in, *diff_lambda, *diff_subln, *na_rpb, *qk_norm, *w_branch, *w_out, *norm_mlp, *w_up, *conv_w, *conv_b, *w_down, *norm_final;
  float* out; char* ws;
  double invA[4], invC[8], invD[16];
  float lam_init[2]; int nseq, pad0;
  unsigned long long seq0, seq1;
};

DEVI unsigned cvtpk(float lo, float hi) { f32x2_t v = {lo, hi}; bf16x2_t b = __builtin_convertvector(v, bf16x2_t); return __builtin_bit_cast(unsigned, b); }
DEVI float bf2f(unsigned short h) { return __uint_as_float(((unsigned)h) << 16); }
DEVI f32x16 mfma(bf16x8 a, bf16x8 b, f32x16 c) { return __builtin_amdgcn_mfma_f32_32x32x16_bf16(a, b, c, 0, 0, 0); }
DEVI int crow(int r, int g) { return (r & 3) + 8 * (r >> 2) + 4 * g; }
DEVI float ex2(float x) { return __builtin_amdgcn_exp2f(x); }
DEVI s16x4 trread(const lchar* p) { return __builtin_bit_cast(s16x4, __builtin_amdgcn_ds_read_tr16_b64_v4i16((LAS s16x4*)p)); }
DEVI int otid() { int t = threadIdx.x; asm volatile("" : "+v"(t)); return t; }
DEVI float wave_sum(float v) {
#pragma unroll
  for (int o = 1; o < 64; o <<= 1) v += __shfl_xor(v, o);
  return v;
}

#define WAITBAR(N) asm volatile("s_waitcnt vmcnt(" #N ") lgkmcnt(0)\n\ts_barrier" ::: "memory")
template <int MI, bool CHAIN = false>
DEVI void gemm_dma(f32x16 (&acc)[MI][2], lchar* lds, const bf16* __restrict__ A, int lda, int arow0, int alo, int ahi,
                   const bf16* __restrict__ B, int ldb, int brow0, int brow1, int K,
                   bool has_prev = false, const bf16* __restrict__ nA = nullptr, int nlda = 0, const bf16* __restrict__ nB = nullptr, int nldb = 0, int nbrow0 = 0, int nbrow1 = 0) {
  constexpr int ABYTES = 64 * MI * 64, STAGE = ABYTES + 16384, NAI = MI / 2;
  const int tid = otid(), lane = tid & 63, wave = __builtin_amdgcn_readfirstlane(tid >> 6), wr = wave >> 2, wc = wave & 3, l32 = lane & 31, g = lane >> 5;
  int offA[NAI], offB[2];
#pragma unroll
  for (int i = 0; i < NAI; ++i) {
    const int r = wave * 8 * MI + 16 * i + (lane >> 2), c = (lane & 3) ^ ((r >> 2) & 3);
    int ar = arow0 + r; ar = ar < alo ? alo : (ar > ahi ? ahi : ar);
    offA[i] = ar * lda + c * 8;
  }
#pragma unroll
  for (int i = 0; i < 2; ++i) {
    const int r = wave * 32 + 16 * i + (lane >> 2), c = (lane & 3) ^ ((r >> 2) & 3);
    const int br = (r < 128) ? brow0 + r : brow1 + r - 128;
    offB[i] = br * ldb + c * 8;
  }
  const bool has_next = CHAIN && (nA != nullptr);
  int noffA[NAI], noffB[2];
  if (CHAIN) {
#pragma unroll
    for (int i = 0; i < NAI; ++i) {
      const int r = wave * 8 * MI + 16 * i + (lane >> 2), c = (lane & 3) ^ ((r >> 2) & 3);
      int ar = arow0 + r; ar = ar < alo ? alo : (ar > ahi ? ahi : ar);
      noffA[i] = ar * nlda + c * 8;
    }
#pragma unroll
    for (int i = 0; i < 2; ++i) {
      const int r = wave * 32 + 16 * i + (lane >> 2), c = (lane & 3) ^ ((r >> 2) & 3);
      const int br = (r < 128) ? nbrow0 + r : nbrow1 + r - 128;
      noffB[i] = br * nldb + c * 8;
    }
  }
  const int ldA = wave * 8 * MI * 64, ldB = ABYTES + wave * 32 * 64;
#define DMA_NEXT(kt, sofs) do { \
    _Pragma("unroll") for (int i_ = 0; i_ < NAI; ++i_) __builtin_amdgcn_global_load_lds((const unsigned*)(nA + noffA[i_] + (kt) * 32), (LAS unsigned*)(lds + (sofs) + ldA + i_ * 1024), 16, 0, 0); \
    _Pragma("unroll") for (int i_ = 0; i_ < 2; ++i_) __builtin_amdgcn_global_load_lds((const unsigned*)(nB + noffB[i_] + (kt) * 32), (LAS unsigned*)(lds + (sofs) + ldB + i_ * 1024), 16, 0, 0); } while (0)
#define DMA_TILE(kt, sofs) do { \
    _Pragma("unroll") for (int i_ = 0; i_ < NAI; ++i_) __builtin_amdgcn_global_load_lds((const unsigned*)(A + offA[i_] + (kt) * 32), (LAS unsigned*)(lds + (sofs) + ldA + i_ * 1024), 16, 0, 0); \
    _Pragma("unroll") for (int i_ = 0; i_ < 2; ++i_) __builtin_amdgcn_global_load_lds((const unsigned*)(B + offB[i_] + (kt) * 32), (LAS unsigned*)(lds + (sofs) + ldB + i_ * 1024), 16, 0, 0); } while (0)
  const int nk = K >> 5;
  if (!(CHAIN && has_prev)) {
    DMA_TILE(0, 0);
    DMA_TILE(1, STAGE);
    DMA_TILE(2, 2 * STAGE);
    if constexpr (MI == 4) WAITBAR(8); else WAITBAR(6);
  }
  const unsigned ldsbase = (unsigned)(size_t)lds;
  const int swz = (l32 >> 2) & 3;
  const int arow = (wr * 32 * MI + l32) * 64, brow = ABYTES + (wc * 64 + l32) * 64;
  const int ck0 = (g ^ swz) * 16, ck1 = ((2 + g) ^ swz) * 16;
#define FRAG_READ(AF, BF, aaddr, baddr) do { \
    _Pragma("unroll") for (int ni_ = 0; ni_ < 2; ++ni_) asm volatile("ds_read_b128 %0, %1 offset:%2" : "=&v"(BF[ni_]) : "v"(baddr), "n"(ni_ * 2048) : "memory"); \
    _Pragma("unroll") for (int mi_ = 0; mi_ < MI; ++mi_) asm volatile("ds_read_b128 %0, %1 offset:%2" : "=&v"(AF[mi_]) : "v"(aaddr), "n"(mi_ * 2048) : "memory"); } while (0)
#define PLAINBAR() asm volatile("s_barrier" ::: "memory")
  bf16x8 af0[MI], bf0[2], af1[MI], bf1[2];
  if (wr == 1) PLAINBAR();
  int cur = 0;
  for (int t = 0; t < nk; ++t) {
    FRAG_READ(af0, bf0, ldsbase + (unsigned)(cur + arow + ck0), ldsbase + (unsigned)(cur + brow + ck0));
    FRAG_READ(af1, bf1, ldsbase + (unsigned)(cur + arow + ck1), ldsbase + (unsigned)(cur + brow + ck1));
    if (t + 2 < nk || has_next) { if constexpr (MI == 4) WAITBAR(4); else WAITBAR(3); }
    else WAITBAR(0);
    int nx = cur + 3 * STAGE; if (nx >= 4 * STAGE) nx -= 4 * STAGE;
    __builtin_amdgcn_sched_barrier(0);
#pragma unroll
    for (int mi = 0; mi < MI; ++mi)
#pragma unroll
      for (int ni = 0; ni < 2; ++ni) acc[mi][ni] = mfma(af0[mi], bf0[ni], acc[mi][ni]);
    __builtin_amdgcn_sched_barrier(0);
    if (t + 3 < nk) DMA_TILE(t + 3, nx);
    else if (has_next) DMA_NEXT(t + 3 - nk, nx);
    __builtin_amdgcn_sched_barrier(0);
#pragma unroll
    for (int mi = 0; mi < MI; ++mi)
#pragma unroll
      for (int ni = 0; ni < 2; ++ni) acc[mi][ni] = mfma(af1[mi], bf1[ni], acc[mi][ni]);
    __builtin_amdgcn_sched_barrier(0);
    PLAINBAR();
    cur += STAGE; if (cur >= 4 * STAGE) cur -= 4 * STAGE;
  }
  if (wr == 0) PLAINBAR();
#undef FRAG_READ
#undef PLAINBAR
#undef DMA_TILE
#undef DMA_NEXT
}

template <int MI>
DEVI void zero_acc(f32x16 (&acc)[MI][2]) {
#pragma unroll
  for (int a = 0; a < MI; ++a)
#pragma unroll
    for (int b = 0; b < 2; ++b)
#pragma unroll
      for (int r = 0; r < 16; ++r) acc[a][b][r] = 0.f;
}

DEVI void acc_to_lds(const f32x16 (&acc)[2][2], lchar* lds) {
  const int tid = otid(), lane = tid & 63, wave = tid >> 6, wr = wave >> 2, wc = wave & 3, l32 = lane & 31, g = lane >> 5;
  LAS float* Cs = (LAS float*)lds;
#pragma unroll
  for (int mi = 0; mi < 2; ++mi)
#pragma unroll
    for (int ni = 0; ni < 2; ++ni)
#pragma unroll
      for (int r = 0; r < 16; ++r) Cs[(wr * 64 + mi * 32 + crow(r, g)) * CP + wc * 64 + ni * 32 + l32] = acc[mi][ni][r];
}
DEVI void acc_to_lds_half(const f32x16 (&acc)[4][2], lchar* lds, int hf, int rowofs) {
  const int tid = otid(), lane = tid & 63, wave = __builtin_amdgcn_readfirstlane(tid >> 6), wr = wave >> 2, wc = wave & 3, l32 = lane & 31, g = lane >> 5;
  LAS float* Cs = (LAS float*)lds;
  if (wr == hf) {
#pragma unroll
    for (int mi = 0; mi < 4; ++mi)
#pragma unroll
      for (int ni = 0; ni < 2; ++ni)
#pragma unroll
        for (int r = 0; r < 16; ++r) Cs[(rowofs + mi * 32 + crow(r, g)) * CP + wc * 64 + ni * 32 + l32] = acc[mi][ni][r];
  }
}

DEVI int xsched_idx(int i) { const int ns = gridDim.x >> 3; return (i * 8 + (int)(blockIdx.x & 7)) * ns + (int)(blockIdx.x >> 3); }
DEVI bool gemm_tile(int idx, int MT, int NT, int& mt, int& nt) { const int mg = idx / (4 * NT), rem = idx - mg * 4 * NT; nt = rem >> 2; mt = mg * 4 + (rem & 3); return mt < MT; }

DEVI void transpose_item(const float* __restrict__ W, int K, int N, bf16* __restrict__ Wt, int item, lchar* lds) {
  const int nnb = N >> 6, kb = item / nnb, nb = item - kb * nnb, tid = otid();
  LAS float* t = (LAS float*)lds;
  __syncthreads();
#pragma unroll
  for (int i = 0; i < 8; ++i) { const int k = (tid >> 6) + 8 * i, n = tid & 63; t[k * 65 + n] = W[(size_t)(kb * 64 + k) * N + nb * 64 + n]; }
  __syncthreads();
  {
    const int n = tid >> 3, kc = tid & 7;
    float v[8];
#pragma unroll
    for (int j = 0; j < 8; ++j) v[j] = t[(kc * 8 + j) * 65 + n];
    u32x4 o; o.x = cvtpk(v[0], v[1]); o.y = cvtpk(v[2], v[3]); o.z = cvtpk(v[4], v[5]); o.w = cvtpk(v[6], v[7]);
    *(u32x4*)(Wt + (size_t)(nb * 64 + n) * K + kb * 64 + kc * 8) = o;
  }
}

DEVI void phase_weights(const Params& p, lchar* lds) {
  constexpr int I_IN = 16 * 108, I_B = 4 * 16, I_OUT = 16 * 16, I_UP = 16 * 88, I_DN = 44 * 16;
  constexpr int T_IN = 2 * I_IN, T_B = 8 * I_B, T_OUT = 2 * I_OUT, T_UP = 2 * I_UP, T_DN = 2 * I_DN;
  constexpr int TOTAL = T_IN + T_B + T_OUT + T_UP + T_DN;
  for (int it = blockIdx.x; it < TOTAL; it += gridDim.x) {
    int r = it;
    if (r < T_IN) { const int l = r / I_IN; transpose_item(p.w_in + (size_t)l * DM * INC, DM, INC, (bf16*)(p.ws + WS_WIN) + (size_t)l * INC * DM, r - l * I_IN, lds); continue; }
    r -= T_IN;
    if (r < T_B) { const int lb = r / I_B; transpose_item(p.w_branch + (size_t)lb * 256 * DM, 256, DM, (bf16*)(p.ws + WS_WB) + (size_t)lb * DM * 256, r - lb * I_B, lds); continue; }
    r -= T_B;
    if (r < T_OUT) { const int l = r / I_OUT; transpose_item(p.w_out + (size_t)l * DM * DM, DM, DM, (bf16*)(p.ws + WS_WOUT) + (size_t)l * DM * DM, r - l * I_OUT, lds); continue; }
    r -= T_OUT;
    if (r < T_UP) { const int l = r / I_UP; transpose_item(p.w_up + (size_t)l * DM * NUP, DM, NUP, (bf16*)(p.ws + WS_WUP) + (size_t)l * NUP * DM, r - l * I_UP, lds); continue; }
    r -= T_UP;
    { const int l = r / I_DN; transpose_item(p.w_down + (size_t)l * DFF * DM, DFF, DM, (bf16*)(p.ws + WS_WDN) + (size_t)l * DM * DFF, r - l * I_DN, lds); }
  }
}

DEVI void phase_norm(const Params& p, int mode, const float* __restrict__ gain) {
  const int lane = otid() & 63, gw = blockIdx.x * 8 + (otid() >> 6), ngw = gridDim.x * 8;
  bf16* H = (bf16*)(p.ws + WS_H);
  f32x4 gg[4];
#pragma unroll
  for (int j = 0; j < 4; ++j) gg[j] = ((const f32x4*)gain)[lane + 64 * j];
  for (int row0 = gw; row0 < MTOK / 2; row0 += ngw) {
    f32x4 v[2][4]; float ss[2];
#pragma unroll
    for (int u = 0; u < 2; ++u) {
      const int row = row0 + u * (MTOK / 2);
      const float* src = (mode == 0) ? (row < 2 * SEQ ? p.xp + (size_t)row * DM : p.xs + (size_t)(row - 2 * SEQ) * DM) : p.out + (size_t)row * DM;
#pragma unroll
      for (int j = 0; j < 4; ++j) v[u][j] = ((const f32x4*)src)[lane + 64 * j];
    }
#pragma unroll
    for (int u = 0; u < 2; ++u) {
      float s = 0.f;
#pragma unroll
      for (int j = 0; j < 4; ++j) s += (v[u][j].x * v[u][j].x + v[u][j].y * v[u][j].y) + (v[u][j].z * v[u][j].z + v[u][j].w * v[u][j].w);
      ss[u] = wave_sum(s);
    }
#pragma unroll
    for (int u = 0; u < 2; ++u) {
      const int row = row0 + u * (MTOK / 2);
      const float rstd = 1.0f / sqrtf(ss[u] * (1.0f / DM) + EPS);
      float* orow = p.out + (size_t)row * DM;
#pragma unroll
      for (int j = 0; j < 4; ++j) {
        const f32x4 y = v[u][j] * rstd * gg[j];
        if (mode == 2) ((f32x4*)orow)[lane + 64 * j] = y;
        else { u32x2 w; w.x = cvtpk(y.x, y.y); w.y = cvtpk(y.z, y.w); ((u32x2*)(H + (size_t)row * DM))[lane + 64 * j] = w; }
      }
    }
  }
}

DEVI void rot(float& a, float& b, double t) {
  const float rv = (float)(t - __builtin_rint(t));
  const float cs = __builtin_amdgcn_cosf(rv), sn = __builtin_amdgcn_sinf(rv);
  const float x1 = a, x2 = b; a = x1 * cs - x2 * sn; b = x2 * cs + x1 * sn;
}

DEVI void phase_qkv(const Params& p, int layer, lchar* lds) {
  const bf16* H = (const bf16*)(p.ws + WS_H);
  const bf16* Wt = (const bf16*)(p.ws + WS_WIN) + (size_t)layer * INC * DM;
  bf16* QKV = (bf16*)(p.ws + WS_QKV);
  const int tid = otid();
  constexpr int NT = 11, MT = MTOK / 256, TILES = MT * NT;
  for (int i = 0;; ++i) {
    const int idx = xsched_idx(i); if (idx >= TILES) break;
    int mt, nt; gemm_tile(idx, MT, NT, mt, nt);
    const int n0 = nt * 256;
    f32x16 acc[4][2]; zero_acc<4>(acc);
    gemm_dma<4>(acc, lds, H, DM, mt * 256, 0, MTOK - 1, Wt, DM, n0, n0 + 128, DM);
    {
      const int lane = tid & 63, wave = __builtin_amdgcn_readfirstlane(tid >> 6), wr = wave >> 2, wc = wave & 3, l32 = lane & 31, g = lane >> 5;
      LAS float* Wp = (LAS float*)(lds + wave * 17408);
      const int G = nt * 4 + wc;
      const float qs = 0.125f * LOG2E;
      const bool isD = (G >= 36 && G < 42);
#pragma unroll
      for (int c2 = 0; c2 < 2; ++c2) {
#pragma unroll
        for (int mi = 0; mi < 2; ++mi)
#pragma unroll
          for (int ni = 0; ni < 2; ++ni)
#pragma unroll
            for (int r = 0; r < 16; ++r) Wp[(mi * 32 + crow(r, g)) * 68 + ni * 32 + l32] = acc[2 * c2 + mi][ni][r];
        asm volatile("s_waitcnt lgkmcnt(0)" ::: "memory");
        const int grow = mt * 256 + wr * 128 + c2 * 64 + lane, pos = grow & (SEQ - 1);
        const LAS float* rowp = Wp + lane * 68;
        float rstd = 1.f;
        if (isD) {
          float ss = 0.f;
#pragma unroll
          for (int i = 0; i < 16; ++i) { const f32x4 t = *(const LAS f32x4*)(rowp + 4 * i); ss += (t.x * t.x + t.y * t.y) + (t.z * t.z + t.w * t.w); }
          rstd = 1.0f / sqrtf(ss * (1.0f / 64.0f) + EPS);
        }
        bf16* dst = QKV + (size_t)grow * NQKV + G * 64;
#pragma unroll 1
        for (int hh = 0; hh < 2; ++hh) {
          float v[32];
#pragma unroll
          for (int i = 0; i < 8; ++i) { const f32x4 t = *(const LAS f32x4*)(rowp + hh * 32 + 4 * i); v[4 * i] = t.x; v[4 * i + 1] = t.y; v[4 * i + 2] = t.z; v[4 * i + 3] = t.w; }
          float sc = 1.f;
          if (G < 8) {
#pragma unroll
            for (int i = 0; i < 4; ++i) rot(v[i], v[4 + i], (double)pos * p.invA[i]);
            if (G < 4) sc = 0.17677669529663687f * LOG2E;
          } else if (G >= 12 && G < 16) { sc = qs;
          } else if (G >= 24 && G < 32) {
            if (hh == 0) {
#pragma unroll
              for (int i = 0; i < 8; ++i) rot(v[i], v[8 + i], (double)pos * p.invC[i]);
            }
            if (G < 28) sc = qs;
          } else if (isD) {
            const float* gq = p.qk_norm + layer * 128 + (G < 40 ? 0 : 64) + hh * 32;
#pragma unroll
            for (int i = 0; i < 32; ++i) v[i] = v[i] * rstd * gq[i];
            const int pa = hh == 0 ? (pos >> 6) : (pos & 63);
#pragma unroll
            for (int i = 0; i < 16; ++i) rot(v[i], v[16 + i], (double)pa * p.invD[i]);
            if (G < 40) sc = qs;
          }
#pragma unroll
          for (int i = 0; i < 4; ++i) {
            u32x4 o; o.x = cvtpk(v[8 * i] * sc, v[8 * i + 1] * sc); o.y = cvtpk(v[8 * i + 2] * sc, v[8 * i + 3] * sc);
            o.z = cvtpk(v[8 * i + 4] * sc, v[8 * i + 5] * sc); o.w = cvtpk(v[8 * i + 6] * sc, v[8 * i + 7] * sc);
            ((u32x4*)(dst + hh * 32))[i] = o;
          }
        }
        asm volatile("s_waitcnt lgkmcnt(0)" ::: "memory");
      }
    }
    __syncthreads();
  }
}

struct FState { float m; bool init; f32x16 negm; f32x16 o[2]; f32x16 ls; };
DEVI void fstate_init(FState& st) {
  st.m = 0.f; st.init = false;
#pragma unroll
  for (int r = 0; r < 16; ++r) { st.negm[r] = 0.f; st.o[0][r] = 0.f; st.o[1][r] = 0.f; st.ls[r] = 0.f; }
}
template <int NKH>
DEVI void flash_update(f32x16 (&s)[NKH], FState& st, const lchar* vb, int dhs, int lane) {
  float mx = s[0][0];
#pragma unroll
  for (int kh = 0; kh < NKH; ++kh)
#pragma unroll
    for (int r = 0; r < 16; ++r) mx = fmaxf(mx, s[kh][r]);
  mx = fmaxf(mx, __shfl_xor(mx, 32));
  const bool fin = mx > -1e30f;
  const bool upd = (mx > 8.0f) || (!st.init && fin);
  st.init = st.init || fin;
  if (__any(upd)) {
    const float d = upd ? mx : 0.f;
    st.m += d;
    const float alpha = ex2(-d);
#pragma unroll
    for (int dh = 0; dh < 2; ++dh)
#pragma unroll
      for (int r = 0; r < 16; ++r) st.o[dh][r] *= alpha;
#pragma unroll
    for (int r = 0; r < 16; ++r) st.ls[r] *= alpha;
#pragma unroll
    for (int kh = 0; kh < NKH; ++kh)
#pragma unroll
      for (int r = 0; r < 16; ++r) s[kh][r] -= d;
    const float nm = -st.m;
#pragma unroll
    for (int r = 0; r < 16; ++r) st.negm[r] = nm;
  }
#pragma unroll
  for (int kh = 0; kh < NKH; ++kh)
#pragma unroll
    for (int r = 0; r < 16; ++r) s[kh][r] = ex2(s[kh][r]);
  const int g = lane >> 5;
  const lchar* vp = vb + (4 * g + ((lane & 15) >> 2)) * 64 + ((lane >> 4) & 1) * 32 + (lane & 3) * 8;
  const bf16x8 ones = {0x3f80, 0x3f80, 0x3f80, 0x3f80, 0x3f80, 0x3f80, 0x3f80, 0x3f80};
#pragma unroll
  for (int kh = 0; kh < NKH; ++kh)
#pragma unroll
    for (int j = 0; j < 2; ++j) {
      u32x4 pw; pw.x = cvtpk(s[kh][8 * j], s[kh][8 * j + 1]); pw.y = cvtpk(s[kh][8 * j + 2], s[kh][8 * j + 3]);
      pw.z = cvtpk(s[kh][8 * j + 4], s[kh][8 * j + 5]); pw.w = cvtpk(s[kh][8 * j + 6], s[kh][8 * j + 7]);
      const bf16x8 pb = __builtin_bit_cast(bf16x8, pw);
#pragma unroll
      for (int dh = 0; dh < 2; ++dh) {
        const s16x4 lo = trread(vp + dh * dhs + (kh * 32 + 16 * j) * 64), hi = trread(vp + dh * dhs + (kh * 32 + 16 * j + 8) * 64);
        const bf16x8 a = {lo[0], lo[1], lo[2], lo[3], hi[0], hi[1], hi[2], hi[3]};
        st.o[dh] = mfma(a, pb, st.o[dh]);
      }
      st.ls = mfma(ones, pb, st.ls);
    }
}

DEVI void write_o(const f32x16 (&o)[2], float sc, bf16* dst, int g) {
#pragma unroll
  for (int dh = 0; dh < 2; ++dh)
#pragma unroll
    for (int r4 = 0; r4 < 4; ++r4) {
      u32x2 w; w.x = cvtpk(o[dh][4 * r4] * sc, o[dh][4 * r4 + 1] * sc); w.y = cvtpk(o[dh][4 * r4 + 2] * sc, o[dh][4 * r4 + 3] * sc);
      *(u32x2*)(dst + 32 * dh + 8 * r4 + 4 * g) = w;
    }
}

constexpr int AT_BUF = 17408, AT_V = 9216;

struct KVRegs { u32x4 k, v; };
DEVI void kv_load(KVRegs& r, const bf16* __restrict__ Kp, const bf16* __restrict__ Vp, int tok0, int tid) {
  const int row = tid >> 3, ch = tid & 7;
  r.k = *(const u32x4*)(Kp + (size_t)(tok0 + row) * NQKV + ch * 8);
  r.v = *(const u32x4*)(Vp + (size_t)(tok0 + row) * NQKV + ch * 8);
}
DEVI void kv_store(const KVRegs& r, lchar* buf, int tid) {
  const int row = tid >> 3, ch = tid & 7;
  *(LAS u32x4*)(buf + row * 144 + ch * 16) = r.k;
  *(LAS u32x4*)(buf + AT_V + (ch >> 2) * 4096 + row * 64 + (ch & 3) * 16) = r.v;
}

template <int NKS>
DEVI void attn_full_loop(const bf16* __restrict__ QKV, int seqbase, int tokq, int qcol, int kcol, int vcol, int kdimofs, FState& st, lchar* lds) {
  const int tid = otid(), lane = tid & 63, l32 = lane & 31, g = lane >> 5;
  bf16x8 qf[NKS];
#pragma unroll
  for (int ks = 0; ks < NKS; ++ks) qf[ks] = *(const bf16x8*)(QKV + (size_t)tokq * NQKV + qcol + 16 * ks + 8 * g);
  const bf16* Kp = QKV + kcol;
  const bf16* Vp = QKV + vcol;
  KVRegs kra[2], krb[2];
  __syncthreads();
#define KV_LOAD2(R, tok) do { kv_load(R[0], Kp, Vp, (tok), tid); kv_load(R[1], Kp, Vp, (tok) + 64, tid); } while (0)
#define KV_STORE2(R, base) do { kv_store(R[0], (base), tid); kv_store(R[1], (base) + AT_BUF, tid); } while (0)
  KV_LOAD2(kra, seqbase);
  KV_LOAD2(krb, seqbase + 128);
  KV_STORE2(kra, lds);
  __syncthreads();
  constexpr int NT2 = SEQ / 128;
#define ATT_TILE(buf) do { f32x16 s[2]; \
    _Pragma("unroll") for (int kh = 0; kh < 2; ++kh) { _Pragma("unroll") for (int ks = 0; ks < NKS; ++ks) { \
      const bf16x8 a_ = *(const LAS bf16x8*)((buf) + (kh * 32 + l32) * 144 + kdimofs + ks * 32 + g * 16); \
      s[kh] = mfma(a_, qf[ks], ks == 0 ? st.negm : s[kh]); } } \
    flash_update<2>(s, st, (buf) + AT_V, 4096, lane); } while (0)
  for (int t = 0; t < NT2; t += 2) {
    if (t + 2 < NT2) KV_LOAD2(kra, seqbase + (t + 2) * 128);
    ATT_TILE(lds);
    ATT_TILE(lds + AT_BUF);
    KV_STORE2(krb, lds + 2 * AT_BUF);
    __syncthreads();
    if (t + 3 < NT2) KV_LOAD2(krb, seqbase + (t + 3) * 128);
    ATT_TILE(lds + 2 * AT_BUF);
    ATT_TILE(lds + 3 * AT_BUF);
    if (t + 2 < NT2) KV_STORE2(kra, lds);
    __syncthreads();
  }
#undef ATT_TILE
#undef KV_LOAD2
#undef KV_STORE2
}

DEVI void attn_A(const Params& p, int layer, int it, lchar* lds) {
  const int seq = it >> 8, h = (it >> 6) & 3, qb = it & 63;
  const int tid = otid(), lane = tid & 63, wave = tid >> 6, l32 = lane & 31, g = lane >> 5;
  const int c = wave & 1, qh = wave >> 1;
  const bf16* QKV = (const bf16*)(p.ws + WS_QKV);
  bf16* O = (bf16*)(p.ws + WS_O);
  const int tokq = seq * SEQ + qb * 128 + qh * 32 + l32;
  FState st; fstate_init(st);
  attn_full_loop<2>(QKV, seq * SEQ, tokq, 64 * h + 32 * c, 256 + 64 * h, 512 + 64 * h, 64 * c, st, lds);
  f32x16 (&o)[2] = st.o;
  const float* lv = p.diff_lambda + layer * 128;
  float d1 = 0.f, d2 = 0.f;
#pragma unroll
  for (int i = 0; i < 32; ++i) { d1 += lv[i] * lv[32 + i]; d2 += lv[64 + i] * lv[96 + i]; }
  const float lam_init = p.lam_init[layer];
  const float lam = expf(d1) - expf(d2) + lam_init;
  const float lt = st.ls[0];
  const float sc = (c == 0) ? 1.0f / lt : lam / lt;
  LAS float* xb = (LAS float*)lds + qh * 2048;
  if (c == 1) {
#pragma unroll
    for (int dh = 0; dh < 2; ++dh)
#pragma unroll
      for (int r = 0; r < 16; ++r) xb[(dh * 16 + r) * 64 + lane] = o[dh][r] * sc;
  }
  __syncthreads();
  if (c == 0) {
    float ss = 0.f;
#pragma unroll
    for (int dh = 0; dh < 2; ++dh)
#pragma unroll
      for (int r = 0; r < 16; ++r) { const float x = o[dh][r] * sc - xb[(dh * 16 + r) * 64 + lane]; o[dh][r] = x; ss += x * x; }
    ss += __shfl_xor(ss, 32);
    const float rstd = (1.0f - lam_init) / sqrtf(ss * (1.0f / 64.0f) + EPS);
    const float* sg = p.diff_subln + layer * 64;
#pragma unroll
    for (int dh = 0; dh < 2; ++dh)
#pragma unroll
      for (int r = 0; r < 16; ++r) o[dh][r] *= sg[32 * dh + crow(r, g)];
    write_o(o, rstd, O + (size_t)tokq * DM + 64 * h, g);
  }
}

DEVI void attn_D(const Params& p, int it, lchar* lds) {
  const int seq = it >> 7, kv = (it >> 6) & 1, qb = it & 63;
  const int tid = otid(), lane = tid & 63, wave = tid >> 6, l32 = lane & 31, g = lane >> 5;
  const bf16* QKV = (const bf16*)(p.ws + WS_QKV);
  bf16* O = (bf16*)(p.ws + WS_O);
  const int hq = 2 * kv + (wave & 1);
  const int tokq = seq * SEQ + qb * 128 + (wave >> 1) * 32 + l32;
  FState st; fstate_init(st);
  attn_full_loop<4>(QKV, seq * SEQ, tokq, 2304 + 64 * hq, 2560 + 64 * kv, 2688 + 64 * kv, 0, st, lds);
  const float lt = st.ls[0];
  write_o(st.o, 1.0f / lt, O + (size_t)tokq * DM + 768 + 64 * hq, g);
}

constexpr int ATB_BIAS = 8 * AT_BUF;
struct KVRegs4 { u32x4 k[4], v[4]; };
DEVI void kvb_load(KVRegs4& r, const bf16* __restrict__ QKV, int tok0, int tid) {
  const int hd = tid >> 7, t7 = tid & 127;
#pragma unroll
  for (int i = 0; i < 4; ++i) {
    const int c = t7 + 128 * i, row = c >> 3, ch = c & 7;
    r.k[i] = *(const u32x4*)(QKV + (size_t)(tok0 + row) * NQKV + 1024 + 64 * hd + ch * 8);
    r.v[i] = *(const u32x4*)(QKV + (size_t)(tok0 + row) * NQKV + 1280 + 64 * hd + ch * 8);
  }
}
DEVI void kvb_store(const KVRegs4& r, lchar* lds, int bufsel, int tid) {
  const int hd = tid >> 7, t7 = tid & 127;
  lchar* buf = lds + (hd * 2 + bufsel) * AT_BUF;
#pragma unroll
  for (int i = 0; i < 4; ++i) {
    const int c = t7 + 128 * i, row = c >> 3, ch = c & 7;
    *(LAS u32x4*)(buf + row * 144 + ch * 16) = r.k[i];
    *(LAS u32x4*)(buf + AT_V + (ch >> 2) * 4096 + row * 64 + (ch & 3) * 16) = r.v[i];
  }
}
DEVI void attn_B(const Params& p, int layer, int it, lchar* lds) {
  const int seq = it >> 7, r = it & 127;
  const int tid = otid(), lane = tid & 63, wave = tid >> 6, l32 = lane & 31, g = lane >> 5;
  const int h = wave >> 1;
  const bf16* QKV = (const bf16*)(p.ws + WS_QKV);
  bf16* O = (bf16*)(p.ws + WS_O);
  const int qc = (wave & 1) * 32 + l32;
  const int tokq = seq * SEQ + r * 64 + qc;
  bf16x8 qf[4];
#pragma unroll
  for (int ks = 0; ks < 4; ++ks) qf[ks] = *(const bf16x8*)(QKV + (size_t)tokq * NQKV + 768 + 64 * h + 16 * ks + 8 * g);
  int rs = r - 4; rs = rs < 0 ? 0 : (rs > 120 ? 120 : rs);
  const int tokk = seq * SEQ + rs * 64;
  LAS float* bias = (LAS float*)(lds + ATB_BIAS) + h * 465;
  const float* rpb = p.na_rpb + (size_t)(layer * 4) * 465;
  FState st; fstate_init(st);
  int cs = qc - 8; cs = cs < 0 ? 0 : (cs > 48 ? 48 : cs);
  __syncthreads();
  for (int i = tid; i < 4 * 465; i += NTHR) ((LAS float*)(lds + ATB_BIAS))[i] = rpb[i] * LOG2E;
  for (int t = 0; t < 8; ++t) {
    __syncthreads();
    { KVRegs4 kr; kvb_load(kr, QKV, tokk + t * 64, tid); kvb_store(kr, lds, 0, tid); }
    __syncthreads();
    lchar* buf = lds + (h * 2) * AT_BUF;
    const int dr = rs + t - r + 7;
    f32x16 s[2];
#pragma unroll
    for (int kh = 0; kh < 2; ++kh) {
#pragma unroll
      for (int ks = 0; ks < 4; ++ks) {
        const bf16x8 a = *(const LAS bf16x8*)(buf + (kh * 32 + l32) * 144 + ks * 32 + g * 16);
        s[kh] = mfma(a, qf[ks], ks == 0 ? st.negm : s[kh]);
      }
#pragma unroll
      for (int rr = 0; rr < 16; ++rr) {
        const int kc = kh * 32 + crow(rr, g);
        int dc = kc - qc + 15; dc = dc < 0 ? 0 : (dc > 30 ? 30 : dc);
        const bool valid = (kc >= cs) && (kc < cs + 16);
        s[kh][rr] = valid ? s[kh][rr] + bias[dr * 31 + dc] : -INFINITY;
      }
    }
    flash_update<2>(s, st, buf + AT_V, 4096, lane);
  }
  const float lt = st.ls[0];
  write_o(st.o, 1.0f / lt, O + (size_t)tokq * DM + 256 + 64 * h, g);
}

constexpr int CW_BUF = 8704, CW_V = 4608;
struct CRegs { u32x4 k[4], v[4]; };
DEVI void c_tile_params(int tg, int& st, int& j0) {
  if (tg < 5) { st = 16; j0 = -64 + 32 * tg; }
  else if (tg < 13) { st = 4; j0 = -64 + 32 * (tg - 5); }
  else { st = 1; j0 = -64 + 32 * (tg - 13); }
}
DEVI void c_load(CRegs& r, const bf16* __restrict__ Kp, const bf16* __restrict__ Vp, int seqbase, int qp0, int tg, int lane) {
  int st, j0; c_tile_params(tg, st, j0);
#pragma unroll
  for (int i = 0; i < 4; ++i) {
    const int c = lane + 64 * i, row = c >> 3, ch = c & 7;
    int kp = qp0 + st * (j0 + row); kp = kp < 0 ? 0 : (kp > SEQ - 1 ? SEQ - 1 : kp);
    r.k[i] = *(const u32x4*)(Kp + (size_t)(seqbase + kp) * NQKV + ch * 8);
    r.v[i] = *(const u32x4*)(Vp + (size_t)(seqbase + kp) * NQKV + ch * 8);
  }
}
DEVI void c_store(const CRegs& r, lchar* wb, int lane) {
#pragma unroll
  for (int i = 0; i < 4; ++i) {
    const int c = lane + 64 * i, row = c >> 3, ch = c & 7;
    *(LAS u32x4*)(wb + row * 144 + ch * 16) = r.k[i];
    *(LAS u32x4*)(wb + CW_V + (ch >> 2) * 2048 + row * 64 + (ch & 3) * 16) = r.v[i];
  }
}
DEVI void attn_C(const Params& p, int it, lchar* lds) {
  const int seq = it >> 7, h = (it >> 5) & 3, span = (it >> 1) & 15, half = it & 1;
  const int tid = otid(), lane = tid & 63, wave = tid >> 6, l32 = lane & 31, g = lane >> 5;
  const bf16* QKV = (const bf16*)(p.ws + WS_QKV);
  bf16* O = (bf16*)(p.ws + WS_O);
  const int rho = half * 8 + wave, qp0 = span * 512 + rho;
  const int seqbase = seq * SEQ;
  const int tokq = seqbase + qp0 + 16 * l32;
  bf16x8 qf[4];
#pragma unroll
  for (int ks = 0; ks < 4; ++ks) qf[ks] = *(const bf16x8*)(QKV + (size_t)tokq * NQKV + 1536 + 64 * h + 16 * ks + 8 * g);
  const bf16* Kp = QKV + 1792 + 64 * h;
  const bf16* Vp = QKV + 2048 + 64 * h;
  lchar* wb = lds + wave * CW_BUF;
  FState fs; fstate_init(fs);
  CRegs cr;
  c_load(cr, Kp, Vp, seqbase, qp0, 0, lane);
  __syncthreads();
  for (int tg = 0; tg < 33; ++tg) {
    asm volatile("" ::: "memory");
    c_store(cr, wb, lane);
    asm volatile("s_waitcnt lgkmcnt(0)" ::: "memory");
    if (tg + 1 < 33) c_load(cr, Kp, Vp, seqbase, qp0, tg + 1, lane);
    int st, j0; c_tile_params(tg, st, j0);
    f32x16 s[1];
#pragma unroll
    for (int ks = 0; ks < 4; ++ks) {
      const bf16x8 a = *(const LAS bf16x8*)(wb + l32 * 144 + ks * 32 + g * 16);
      s[0] = mfma(a, qf[ks], ks == 0 ? fs.negm : s[0]);
    }
#pragma unroll
    for (int rr = 0; rr < 16; ++rr) {
      const int jj = j0 + crow(rr, g);
      const int kp = qp0 + st * jj;
      int dd = 16 * l32 - st * jj; dd = dd < 0 ? -dd : dd;
      const bool valid = (dd <= 64 * st) && (kp >= 0) && (kp < SEQ);
      s[0][rr] = valid ? s[0][rr] : -INFINITY;
    }
    flash_update<1>(s, fs, wb + CW_V, 2048, lane);
  }
  const float lt = fs.ls[0];
  write_o(fs.o, 1.0f / lt, O + (size_t)tokq * DM + 512 + 64 * h, g);
}

DEVI void phase_attn(const Params& p, int layer, lchar* lds) {
  constexpr int NA = NSEQ * 4 * 64, ND = NSEQ * 2 * 64, NB = NSEQ * 128, NC = NSEQ * 4 * 16 * 2;
  for (int i = 0;; ++i) {
    const int it = xsched_idx(i); if (it >= NA + ND + NB + NC) break;
    if (it < NA) attn_A(p, layer, it, lds);
    else if (it < NA + ND) attn_D(p, it - NA, lds);
    else if (it < NA + ND + NB) attn_B(p, layer, it - NA - ND, lds);
    else attn_C(p, it - NA - ND - NB, lds);
    __syncthreads();
  }
}

DEVI void phase_merge(const Params& p, int layer, lchar* lds) {
  const bf16* H = (const bf16*)(p.ws + WS_H);
  const bf16* Ob = (const bf16*)(p.ws + WS_O);
  const bf16* Wt = (const bf16*)(p.ws + WS_WIN) + (size_t)layer * INC * DM;
  const bf16* Wb = (const bf16*)(p.ws + WS_WB) + (size_t)layer * 4 * DM * 256;
  bf16* MG = (bf16*)(p.ws + WS_QKV);
  constexpr int NT = 4, MT = MTOK / 128, TILES = MT * NT;
  for (int i = 0;; ++i) {
    const int idx = xsched_idx(i); if (idx >= TILES) break;
    const int tid = otid();
    int mt, nt; gemm_tile(idx, MT, NT, mt, nt);
    const int m0 = mt * 128, n0 = nt * 256;
    unsigned mgp[2][2][8];
#pragma unroll
    for (int mi = 0; mi < 2; ++mi)
#pragma unroll
      for (int ni = 0; ni < 2; ++ni)
#pragma unroll
        for (int j = 0; j < 8; ++j) mgp[mi][ni][j] = 0u;
    for (int b = 0; b < 4; ++b) {
      f32x16 acc[2][2]; zero_acc<2>(acc);
      const int gr = NQKV + b * DM + n0;
      gemm_dma<2, true>(acc, lds, H, DM, m0, 0, MTOK - 1, Wt, DM, gr, gr + 128, DM,
                        b > 0, Ob + 256 * b, DM, Wb + (size_t)b * DM * 256, 256, n0, n0 + 128);
      unsigned sg[2][2][8];
#pragma unroll
      for (int mi = 0; mi < 2; ++mi)
#pragma unroll
        for (int ni = 0; ni < 2; ++ni)
#pragma unroll
          for (int j = 0; j < 8; ++j) {
            const float s0 = __builtin_amdgcn_rcpf(1.0f + ex2(-acc[mi][ni][2 * j] * LOG2E));
            const float s1 = __builtin_amdgcn_rcpf(1.0f + ex2(-acc[mi][ni][2 * j + 1] * LOG2E));
            sg[mi][ni][j] = cvtpk(s0, s1);
          }
      zero_acc<2>(acc);
      gemm_dma<2, true>(acc, lds, Ob + 256 * b, DM, m0, 0, MTOK - 1, Wb + (size_t)b * DM * 256, 256, n0, n0 + 128, 256,
                        true, b < 3 ? H : nullptr, DM, Wt, DM, gr + DM, gr + DM + 128);
#pragma unroll
      for (int mi = 0; mi < 2; ++mi)
#pragma unroll
        for (int ni = 0; ni < 2; ++ni)
#pragma unroll
          for (int j = 0; j < 8; ++j) {
            const unsigned w = sg[mi][ni][j], mo = mgp[mi][ni][j];
            const float lo = __uint_as_float(mo << 16) + __uint_as_float(w << 16) * acc[mi][ni][2 * j];
            const float hi = __uint_as_float(mo & 0xffff0000u) + __uint_as_float(w & 0xffff0000u) * acc[mi][ni][2 * j + 1];
            mgp[mi][ni][j] = cvtpk(lo, hi);
          }
    }
    f32x16 mg[2][2];
#pragma unroll
    for (int mi = 0; mi < 2; ++mi)
#pragma unroll
      for (int ni = 0; ni < 2; ++ni)
#pragma unroll
        for (int j = 0; j < 8; ++j) { mg[mi][ni][2 * j] = __uint_as_float(mgp[mi][ni][j] << 16); mg[mi][ni][2 * j + 1] = __uint_as_float(mgp[mi][ni][j] & 0xffff0000u); }
    acc_to_lds(mg, lds);
    __syncthreads();
    {
      const LAS float* Cs = (const LAS float*)lds;
#pragma unroll
      for (int k = 0; k < 8; ++k) {
        const int id = tid + 512 * k, row = id >> 5, ch = id & 31;
        const f32x4 a = *(const LAS f32x4*)(Cs + row * CP + ch * 8), b2 = *(const LAS f32x4*)(Cs + row * CP + ch * 8 + 4);
        u32x4 o; o.x = cvtpk(a.x, a.y); o.y = cvtpk(a.z, a.w); o.z = cvtpk(b2.x, b2.y); o.w = cvtpk(b2.z, b2.w);
        *(u32x4*)(MG + (size_t)(m0 + row) * DM + n0 + ch * 8) = o;
      }
    }
    __syncthreads();
  }
}

DEVI void phase_resid(const Params& p, float* xout, const bf16* A, int lda, const bf16* Wt, int K, lchar* lds, bool from_inputs) {
  const int tid = otid();
  constexpr int NT = 4, MT = MTOK / 256, TILES = MT * NT;
  for (int i = 0;; ++i) {
    const int idx = xsched_idx(i); if (idx >= TILES) break;
    int mt, nt; gemm_tile(idx, MT, NT, mt, nt);
    const int n0 = nt * 256;
    f32x16 acc[4][2]; zero_acc<4>(acc);
    gemm_dma<4>(acc, lds, A, lda, mt * 256, 0, MTOK - 1, Wt, K, n0, n0 + 128, K);
    for (int hf = 0; hf < 2; ++hf) {
      const int m0 = mt * 256 + hf * 128;
      acc_to_lds_half(acc, lds, hf, 0);
      __syncthreads();
      const LAS float* Cs = (const LAS float*)lds;
#pragma unroll
      for (int k = 0; k < 16; ++k) {
        const int id = tid + 512 * k, row = id >> 6, c4 = id & 63;
        const f32x4 a = *(const LAS f32x4*)(Cs + row * CP + c4 * 4);
        const int grow = m0 + row;
        f32x4* xp = (f32x4*)(xout + (size_t)grow * DM + n0 + c4 * 4);
        const float* xsrc = !from_inputs ? (const float*)xp : (grow < 2 * SEQ ? p.xp + (size_t)grow * DM : p.xs + (size_t)(grow - 2 * SEQ) * DM) + n0 + c4 * 4;
        *xp = *(const f32x4*)xsrc + a;
      }
      __syncthreads();
    }
  }
}

DEVI float gelu_exact(float v) {
  const float av = fabsf(v), t = __builtin_amdgcn_rcpf(av * 0.2316418882f + 1.0f);
  float q = t * 0.5307027145f + (-0.7265760135f); q = q * t + 0.7107068705f; q = q * t + (-0.142248368f); q = q * t + 0.127414796f; q = q * t;
  const float e = ex2((v * v) * (-0.72134752044f));
  const float mm = v * (q * e);
  return v < 0.f ? mm : v - mm;
}
DEVI void phase_up(const Params& p, int layer, lchar* lds) {
  const bf16* H = (const bf16*)(p.ws + WS_H);
  const bf16* Wt = (const bf16*)(p.ws + WS_WUP) + (size_t)layer * NUP * DM;
  bf16* ACT = (bf16*)(p.ws + WS_QKV);
  const float* cw = p.conv_w + (size_t)layer * 3 * NUP;
  const float* cb = p.conv_b + (size_t)layer * NUP;
  const int tid = otid(), lane = tid & 63, wave = __builtin_amdgcn_readfirstlane(tid >> 6), wr = wave >> 2, wc = wave & 3, l32 = lane & 31, g = lane >> 5;
  constexpr int MT = 33, NT = 22, SMT = NSEQ * MT, TILES = ((SMT + 3) / 4) * 4 * NT;
  for (int i = 0;; ++i) {
    const int idx = xsched_idx(i); if (idx >= TILES) break;
    int sm, nt; if (!gemm_tile(idx, SMT, NT, sm, nt)) continue;
    const int seq = sm / MT, mt = sm - seq * MT;
    const int seqbase = seq * SEQ, p0 = 254 * mt - 1;
    f32x16 acc[4][2]; zero_acc<4>(acc);
    gemm_dma<4>(acc, lds, H, DM, seqbase + p0, seqbase, seqbase + SEQ - 1, Wt, DM, 128 * nt, DFF + 128 * nt, DM);
    for (int hf = 0; hf < 2; ++hf) {
      LAS float* Cw = (LAS float*)lds;
      acc_to_lds_half(acc, lds, hf, hf);
      if (hf == 0 && wr == 1 && g == 0) {
#pragma unroll
        for (int ni = 0; ni < 2; ++ni) Cw[128 * CP + wc * 64 + ni * 32 + l32] = acc[0][ni][0];
      }
      if (hf == 1 && wr == 0 && g == 1) {
#pragma unroll
        for (int ni = 0; ni < 2; ++ni) Cw[wc * 64 + ni * 32 + l32] = acc[3][ni][15];
      }
      __syncthreads();
      const LAS float* Cs = (const LAS float*)lds;
#pragma unroll 1
      for (int k = 0; k < 4; ++k) {
        const int id = tid + 512 * k, lr = 1 + (id >> 4), ch = id & 15, pp = p0 + 127 * hf + lr;
        if (lr <= 127 && pp < SEQ) {
          const int c0 = 128 * nt + ch * 8;
          const float wp = pp > 0 ? 1.f : 0.f, wn = pp < SEQ - 1 ? 1.f : 0.f;
#pragma unroll 1
          for (int hh = 0; hh < 2; ++hh) {
            const f32x4 um = *(const LAS f32x4*)(Cs + (lr - 1) * CP + ch * 8 + 4 * hh), uc = *(const LAS f32x4*)(Cs + lr * CP + ch * 8 + 4 * hh),
                        un = *(const LAS f32x4*)(Cs + (lr + 1) * CP + ch * 8 + 4 * hh);
            const f32x4 w0 = *(const f32x4*)(cw + c0 + 4 * hh), w1 = *(const f32x4*)(cw + NUP + c0 + 4 * hh), w2 = *(const f32x4*)(cw + 2 * NUP + c0 + 4 * hh), bb = *(const f32x4*)(cb + c0 + 4 * hh);
            const f32x4 val = um * w0 * wp + uc * w1 + un * w2 * wn + bb;
            const f32x4 gm = *(const LAS f32x4*)(Cs + (lr - 1) * CP + 128 + ch * 8 + 4 * hh), gc = *(const LAS f32x4*)(Cs + lr * CP + 128 + ch * 8 + 4 * hh),
                        gn = *(const LAS f32x4*)(Cs + (lr + 1) * CP + 128 + ch * 8 + 4 * hh);
            const f32x4 v0 = *(const f32x4*)(cw + DFF + c0 + 4 * hh), v1 = *(const f32x4*)(cw + NUP + DFF + c0 + 4 * hh), v2 = *(const f32x4*)(cw + 2 * NUP + DFF + c0 + 4 * hh), vb = *(const f32x4*)(cb + DFF + c0 + 4 * hh);
            const f32x4 gt = gm * v0 * wp + gc * v1 + gn * v2 * wn + vb;
            u32x2 o; o.x = cvtpk(gelu_exact(gt.x) * val.x, gelu_exact(gt.y) * val.y); o.y = cvtpk(gelu_exact(gt.z) * val.z, gelu_exact(gt.w) * val.w);
            *(u32x2*)(ACT + (size_t)(seqbase + pp) * DFF + c0 + 4 * hh) = o;
          }
        }
      }
      __syncthreads();
    }
  }
}

#define XB_TMO      128
#define XB_XCNT(j)  (256  + 64 * (j))
#define XB_XSUB(j)  (1280 + 64 * (j))
#define XB_XGEN(j)  (2304 + 64 * (j))
#define XB_TOP      3328
#define XB_TOPGEN   3392
#define XCD_BAR_WORDS 3456
#define XB_SPIN_CAP (1u << 22)
DEVI unsigned xb_ld(unsigned* p)              { return __hip_atomic_load(p, __ATOMIC_RELAXED, __HIP_MEMORY_SCOPE_AGENT); }
DEVI unsigned xb_add(unsigned* p, unsigned v) { return __hip_atomic_fetch_add(p, v, __ATOMIC_RELAXED, __HIP_MEMORY_SCOPE_AGENT); }
DEVI unsigned xb_xcc_id() { return (unsigned)__builtin_amdgcn_s_getreg((3 << 11) | 20) & 0xFu; }
#define XB_SPIN(cond, bar) do { unsigned _sp = 0; while (cond) { __builtin_amdgcn_s_sleep(1); \
    if ((++_sp & 255u) == 0u) { if (xb_ld(&(bar)[XB_TMO])) break; if (_sp > XB_SPIN_CAP) { atomicAdd(&(bar)[XB_TMO], 1u); break; } } } } while (0)
struct XcdBarrier { unsigned* bar; unsigned x; volatile LAS unsigned* st; };
DEVI XcdBarrier xcd_barrier_post(unsigned* bar, volatile LAS unsigned* st) {
  XcdBarrier b; b.bar = bar; b.x = xb_xcc_id(); b.st = st;
  if (threadIdx.x == 0) (void)xb_add(&bar[XB_XCNT(b.x)], 1u);
  return b;
}
DEVI void xcd_barrier_complete(unsigned* bar, unsigned x, unsigned& nloc, unsigned& nx) {
  const unsigned G = gridDim.x * gridDim.y * gridDim.z;
  unsigned sum, cnt, mine, sp = 0u;
  for (;;) {
    sum = 0u; cnt = 0u; mine = 0u;
#pragma unroll
    for (unsigned j = 0; j < 16; ++j) { const unsigned c = xb_ld(&bar[XB_XCNT(j)]); sum += c; cnt += (c > 0u) ? 1u : 0u; mine = (j == x) ? c : mine; }
    if (sum == G) break;
    __builtin_amdgcn_s_sleep(1);
    if ((++sp & 255u) == 0u) { if (xb_ld(&bar[XB_TMO])) break; if (sp > XB_SPIN_CAP) { atomicAdd(&bar[XB_TMO], 1u); break; } }
  }
  nloc = mine > 0u ? mine : 1u; nx = cnt > 0u ? cnt : 1u;
}
DEVI void xcd_barrier(const XcdBarrier& b) {
  asm volatile("s_waitcnt vmcnt(0)" ::: "memory");
  __syncthreads();
  if (threadIdx.x == 0) {
    unsigned* bar = b.bar;
    __builtin_amdgcn_s_waitcnt(0);
    unsigned nloc = b.st[0], nx = b.st[1];
    if (nloc == 0u) { xcd_barrier_complete(bar, b.x, nloc, nx); b.st[0] = nloc; b.st[1] = nx; }
    const unsigned old = xb_add(&bar[XB_XSUB(b.x)], 1u);
    const unsigned gen = old / nloc;
    if (old + 1u == (gen + 1u) * nloc) {
      __builtin_amdgcn_fence(__ATOMIC_RELEASE, "agent");
      asm volatile("s_waitcnt vmcnt(0)" ::: "memory");
      const unsigned og = xb_add(&bar[XB_TOP], 1u);
      const unsigned tg = og / nx;
      if (og + 1u == (tg + 1u) * nx) xb_add(&bar[XB_TOPGEN], 1u);
      else XB_SPIN(xb_ld(&bar[XB_TOPGEN]) == tg, bar);
      __builtin_amdgcn_fence(__ATOMIC_ACQUIRE, "agent");
      xb_add(&bar[XB_XGEN(b.x)], 1u);
      asm volatile("s_waitcnt vmcnt(0)" ::: "memory");
    } else {
      XB_SPIN(xb_ld(&bar[XB_XGEN(b.x)]) == gen, bar);
      __builtin_amdgcn_fence(__ATOMIC_ACQUIRE, "agent");
      asm volatile("s_waitcnt vmcnt(0)" ::: "memory");
    }
  }
  __syncthreads();
}

constexpr int NPHASE = 17;
__global__ void __launch_bounds__(NTHR, 2) fwd_kernel(Params p) {
  __shared__ __attribute__((aligned(16))) char lds_raw[LDS_BYTES];
  __shared__ unsigned xb_state[2];
  lchar* lds = (lchar*)lds_raw;
  if (threadIdx.x < 2) xb_state[threadIdx.x] = 0u;
  __syncthreads();
  if (p.nseq == 12345) cg::this_grid().sync();
  const XcdBarrier xbar = xcd_barrier_post((unsigned*)(p.ws + WS_CTL), (volatile LAS unsigned*)xb_state);
#define GRID_SYNC() xcd_barrier(xbar)
  for (int i = 0; i < p.nseq; ++i) {
    if (i) GRID_SYNC();
    const int ph = (int)(((i < 12) ? (p.seq0 >> (5 * i)) : (p.seq1 >> (5 * (i - 12)))) & 31ull);
    if (ph == 0) { phase_weights(p, lds); phase_norm(p, 0, p.norm_attn); continue; }
    const int layer = (ph - 1) >> 3, sub = (ph - 1) & 7;
    switch (sub) {
      case 0: phase_qkv(p, layer, lds); break;
      case 1: phase_attn(p, layer, lds); break;
      case 2: phase_merge(p, layer, lds); break;
      case 3: phase_resid(p, p.out, (const bf16*)(p.ws + WS_QKV), DM, (const bf16*)(p.ws + WS_WOUT) + (size_t)layer * DM * DM, DM, lds, layer == 0); break;
      case 4: phase_norm(p, 1, p.norm_mlp + layer * DM); break;
      case 5: phase_up(p, layer, lds); break;
      case 6: phase_resid(p, p.out, (const bf16*)(p.ws + WS_QKV), DFF, (const bf16*)(p.ws + WS_WDN) + (size_t)layer * DM * DFF, DFF, lds, false); break;
      default: if (layer == 0) phase_norm(p, 1, p.norm_attn + DM); else phase_norm(p, 2, p.norm_final); break;
    }
  }
}

extern "C" void kernel_launch(void* const* d_in, const int* in_sizes, int n_in, void* d_out, int out_size, void* d_ws, size_t ws_size, hipStream_t stream) {
  static int grid = 0;
  if (grid == 0) {
    if (n_in != 16 || out_size != MTOK * DM || ws_size < WS_END) { fprintf(stderr, "kernel_launch: unexpected shapes (n_in %d out %d ws %zu need %zu)\n", n_in, out_size, ws_size, (size_t)WS_END); grid = -1; return; }
    int dev = 0, cus = 0, per_cu = 0;
    hipGetDevice(&dev);
    hipDeviceGetAttribute(&cus, hipDeviceAttributeMultiprocessorCount, dev);
    hipOccupancyMaxActiveBlocksPerMultiprocessor(&per_cu, fwd_kernel, NTHR, 0);
    if (per_cu < 1) per_cu = 1;
    if (per_cu > 1) per_cu = 1;
    grid = (cus * per_cu) & ~7;
    if (grid < 8) grid = -1;
  }
  if (grid < 0) return;
  Params p{};
  p.xp = (const float*)d_in[0]; p.xs = (const float*)d_in[1]; p.norm_attn = (const float*)d_in[2]; p.w_in = (const float*)d_in[3];
  p.diff_lambda = (const float*)d_in[4]; p.diff_subln = (const float*)d_in[5]; p.na_rpb = (const float*)d_in[6]; p.qk_norm = (const float*)d_in[7];
  p.w_branch = (const float*)d_in[8]; p.w_out = (const float*)d_in[9]; p.norm_mlp = (const float*)d_in[10]; p.w_up = (const float*)d_in[11];
  p.conv_w = (const float*)d_in[12]; p.conv_b = (const float*)d_in[13]; p.w_down = (const float*)d_in[14]; p.norm_final = (const float*)d_in[15];
  p.out = (float*)d_out; p.ws = (char*)d_ws;
  const double TWO_PI = 6.283185307179586476925286766559;
  for (int i = 0; i < 4; ++i) p.invA[i] = std::exp(-std::log(500000.0) * i / 4.0) / TWO_PI;
  for (int i = 0; i < 8; ++i) p.invC[i] = std::exp(-std::log(500000.0) * i / 8.0) / TWO_PI;
  for (int i = 0; i < 16; ++i) p.invD[i] = std::exp(-std::log(10000.0) * i / 16.0) / TWO_PI;
  for (int l = 0; l < 2; ++l) p.lam_init[l] = (float)(0.8 - 0.6 * std::exp(-0.3 * l));
  if (hipMemsetAsync((char*)d_ws + WS_CTL, 0, CTL_BYTES, stream) != hipSuccess) { fprintf(stderr, "kernel_launch: memset of barrier words failed\n"); return; }
  int codes[24]; int n = 0;
  for (int ph = 0; ph < NPHASE; ++ph) { codes[n++] = ph; if (ph > 0 && ((PROBE_DUP >> ((ph - 1) & 7)) & 1)) codes[n++] = ph; }
  p.nseq = n; p.seq0 = 0; p.seq1 = 0;
  for (int i = 0; i < n; ++i) { if (i < 12) p.seq0 |= (unsigned long long)codes[i] << (5 * i); else p.seq1 |= (unsigned long long)codes[i] << (5 * (i - 12)); }
  void* args[] = {&p};
  hipError_t e = hipLaunchCooperativeKernel((void*)fwd_kernel, dim3(grid), dim3(NTHR), args, 0, stream);
  if (e != hipSuccess) fprintf(stderr, "cooperative launch failed: %s (grid %d)\n", hipGetErrorString(e), grid);
}
```

```cpp
#include <hip/hip_runtime.h>
#include <hip/hip_cooperative_groups.h>
#include <cstdio>
#include <cmath>
namespace cg = cooperative_groups;

#ifndef MEGA
#define MEGA 1
#endif

#ifndef PROBE_DUP
#define PROBE_DUP 0
#endif
#define DEVI __device__ __forceinline__
#define LAS __attribute__((address_space(3)))
typedef unsigned short bf16;
typedef short bf16x8 __attribute__((ext_vector_type(8)));
typedef short s16x4 __attribute__((ext_vector_type(4)));
typedef float f32x16 __attribute__((ext_vector_type(16)));
typedef float f32x4 __attribute__((ext_vector_type(4)));
typedef float f32x2_t __attribute__((ext_vector_type(2)));
typedef __bf16 bf16x2_t __attribute__((ext_vector_type(2)));
typedef unsigned u32x4 __attribute__((ext_vector_type(4)));
typedef unsigned u32x2 __attribute__((ext_vector_type(2)));
typedef LAS char lchar;

constexpr int DM = 1024, SEQ = 8192, NSEQ = 10, MTOK = NSEQ * SEQ, NQKV = 2816, INC = 6912, DFF = 2816, NUP = 5632;
constexpr float LOG2E = 1.4426950408889634f;
constexpr float EPS = 1e-6f;
constexpr int NTHR = 512;
constexpr int LDS_BYTES = 147456;
constexpr int CP = 260;

constexpr size_t SZ_WIN = (size_t)2 * INC * DM * 2, SZ_WB = (size_t)2 * 4 * DM * 256 * 2, SZ_WOUT = (size_t)2 * DM * DM * 2,
                 SZ_WUP = (size_t)2 * NUP * DM * 2, SZ_WDN = (size_t)2 * DM * DFF * 2;
constexpr size_t WS_WIN = 0, WS_WB = WS_WIN + SZ_WIN, WS_WOUT = WS_WB + SZ_WB, WS_WUP = WS_WOUT + SZ_WOUT, WS_WDN = WS_WUP + SZ_WUP;
constexpr size_t WS_H = WS_WDN + SZ_WDN;
constexpr size_t WS_O = WS_H + (size_t)MTOK * DM * 2;
constexpr size_t WS_QKV = WS_O + (size_t)MTOK * DM * 2;
constexpr size_t WS_CTL = WS_QKV + (size_t)MTOK * NQKV * 2;
constexpr size_t CTL_BYTES = 16384;
constexpr size_t WS_END = WS_CTL + CTL_BYTES;

struct Params {
  const float *xp, *xs, *norm_attn, *w_in, *diff_lambda, *diff_subln, *na_rpb, *qk_norm, *w_branch, *w_out, *norm_mlp, *w_up, *conv_w, *conv_b, *w_down, *norm_final;
  float* out; char* ws;
  double invA[4], invC[8], invD[16];
  float lam_init[2]; int nseq, pad0;
  unsigned long long seq0, seq1;
};

DEVI unsigned cvtpk(float lo, float hi) { f32x2_t v = {lo, hi}; bf16x2_t b = __builtin_convertvector(v, bf16x2_t); return __builtin_bit_cast(unsigned, b); }
DEVI float bf2f(unsigned short h) { return __uint_as_float(((unsigned)h) << 16); }
DEVI f32x16 mfma(bf16x8 a, bf16x8 b, f32x16 c) { return __builtin_amdgcn_mfma_f32_32x32x16_bf16(a, b, c, 0, 0, 0); }
DEVI int crow(int r, int g) { return (r & 3) + 8 * (r >> 2) + 4 * g; }
DEVI float ex2(float x) { return __builtin_amdgcn_exp2f(x); }
DEVI s16x4 trread(const lchar* p) { return __builtin_bit_cast(s16x4, __builtin_amdgcn_ds_read_tr16_b64_v4i16((LAS s16x4*)p)); }
DEVI int otid() { int t = threadIdx.x; asm volatile("" : "+v"(t)); return t; }
DEVI float wave_sum(float v) {
#pragma unroll
  for (int o = 1; o < 64; o <<= 1) v += __shfl_xor(v, o);
  return v;
}

#define WAITBAR(N) asm volatile("s_waitcnt vmcnt(" #N ") lgkmcnt(0)\n\ts_barrier" ::: "memory")
template <int MI, bool CHAIN = false>
DEVI void gemm_dma(f32x16 (&acc)[MI][2], lchar* lds, const bf16* __restrict__ A, int lda, int arow0, int alo, int ahi,
                   const bf16* __restrict__ B, int ldb, int brow0, int brow1, int K,
                   bool has_prev = false, const bf16* __restrict__ nA = nullptr, int nlda = 0, const bf16* __restrict__ nB = nullptr, int nldb = 0, int nbrow0 = 0, int nbrow1 = 0) {
  constexpr int ABYTES = 64 * MI * 64, STAGE = ABYTES + 16384, NAI = MI / 2;
  const int tid = otid(), lane = tid & 63, wave = __builtin_amdgcn_readfirstlane(tid >> 6), wr = wave >> 2, wc = wave & 3, l32 = lane & 31, g = lane >> 5;
  int offA[NAI], offB[2];
#pragma unroll
  for (int i = 0; i < NAI; ++i) {
    const int r = wave * 8 * MI + 16 * i + (lane >> 2), c = (lane & 3) ^ ((r >> 2) & 3);
    int ar = arow0 + r; ar = ar < alo ? alo : (ar > ahi ? ahi : ar);
    offA[i] = ar * lda + c * 8;
  }
#pragma unroll
  for (int i = 0; i < 2; ++i) {
    const int r = wave * 32 + 16 * i + (lane >> 2), c = (lane & 3) ^ ((r >> 2) & 3);
    const int br = (r < 128) ? brow0 + r : brow1 + r - 128;
    offB[i] = br * ldb + c * 8;
  }
  const bool has_next = CHAIN && (nA != nullptr);
  int noffA[NAI], noffB[2];
  if (CHAIN) {
#pragma unroll
    for (int i = 0; i < NAI; ++i) {
      const int r = wave * 8 * MI + 16 * i + (lane >> 2), c = (lane & 3) ^ ((r >> 2) & 3);
      int ar = arow0 + r; ar = ar < alo ? alo : (ar > ahi ? ahi : ar);
      noffA[i] = ar * nlda + c * 8;
    }
#pragma unroll
    for (int i = 0; i < 2; ++i) {
      const int r = wave * 32 + 16 * i + (lane >> 2), c = (lane & 3) ^ ((r >> 2) & 3);
      const int br = (r < 128) ? nbrow0 + r : nbrow1 + r - 128;
      noffB[i] = br * nldb + c * 8;
    }
  }
  const int ldA = wave * 8 * MI * 64, ldB = ABYTES + wave * 32 * 64;
#define DMA_NEXT(kt, sofs) do { \
    _Pragma("unroll") for (int i_ = 0; i_ < NAI; ++i_) __builtin_amdgcn_global_load_lds((const unsigned*)(nA + noffA[i_] + (kt) * 32), (LAS unsigned*)(lds + (sofs) + ldA + i_ * 1024), 16, 0, 0); \
    _Pragma("unroll") for (int i_ = 0; i_ < 2; ++i_) __builtin_amdgcn_global_load_lds((const unsigned*)(nB + noffB[i_] + (kt) * 32), (LAS unsigned*)(lds + (sofs) + ldB + i_ * 1024), 16, 0, 0); } while (0)
#define DMA_TILE(kt, sofs) do { \
    _Pragma("unroll") for (int i_ = 0; i_ < NAI; ++i_) __builtin_amdgcn_global_load_lds((const unsigned*)(A + offA[i_] + (kt) * 32), (LAS unsigned*)(lds + (sofs) + ldA + i_ * 1024), 16, 0, 0); \
    _Pragma("unroll") for (int i_ = 0; i_ < 2; ++i_) __builtin_amdgcn_global_load_lds((const unsigned*)(B + offB[i_] + (kt) * 32), (LAS unsigned*)(lds + (sofs) + ldB + i_ * 1024), 16, 0, 0); } while (0)
  const int nk = K >> 5;
  if (!(CHAIN && has_prev)) {
    DMA_TILE(0, 0);
    DMA_TILE(1, STAGE);
    DMA_TILE(2, 2 * STAGE);
    if constexpr (MI == 4) WAITBAR(8); else WAITBAR(6);
  }
  const unsigned ldsbase = (unsigned)(size_t)lds;
  const int swz = (l32 >> 2) & 3;
  const int arow = (wr * 32 * MI + l32) * 64, brow = ABYTES + (wc * 64 + l32) * 64;
  const int ck0 = (g ^ swz) * 16, ck1 = ((2 + g) ^ swz) * 16;
#define FRAG_READ(AF, BF, aaddr, baddr) do { \
    _Pragma("unroll") for (int ni_ = 0; ni_ < 2; ++ni_) asm volatile("ds_read_b128 %0, %1 offset:%2" : "=&v"(BF[ni_]) : "v"(baddr), "n"(ni_ * 2048) : "memory"); \
    _Pragma("unroll") for (int mi_ = 0; mi_ < MI; ++mi_) asm volatile("ds_read_b128 %0, %1 offset:%2" : "=&v"(AF[mi_]) : "v"(aaddr), "n"(mi_ * 2048) : "memory"); } while (0)
#define PLAINBAR() asm volatile("s_barrier" ::: "memory")
  bf16x8 af0[MI], bf0[2], af1[MI], bf1[2];
  if (wr == 1) PLAINBAR();
  int cur = 0;
  for (int t = 0; t < nk; ++t) {
    FRAG_READ(af0, bf0, ldsbase + (unsigned)(cur + arow + ck0), ldsbase + (unsigned)(cur + brow + ck0));
    FRAG_READ(af1, bf1, ldsbase + (unsigned)(cur + arow + ck1), ldsbase + (unsigned)(cur + brow + ck1));
    if (t + 2 < nk || has_next) { if constexpr (MI == 4) WAITBAR(4); else WAITBAR(3); }
    else WAITBAR(0);
    int nx = cur + 3 * STAGE; if (nx >= 4 * STAGE) nx -= 4 * STAGE;
    __builtin_amdgcn_sched_barrier(0);
#pragma unroll
    for (int mi = 0; mi < MI; ++mi)
#pragma unroll
      for (int ni = 0; ni < 2; ++ni) acc[mi][ni] = mfma(af0[mi], bf0[ni], acc[mi][ni]);
    __builtin_amdgcn_sched_barrier(0);
    if (t + 3 < nk) DMA_TILE(t + 3, nx);
    else if (has_next) DMA_NEXT(t + 3 - nk, nx);
    __builtin_amdgcn_sched_barrier(0);
#pragma unroll
    for (int mi = 0; mi < MI; ++mi)
#pragma unroll
      for (int ni = 0; ni < 2; ++ni) acc[mi][ni] = mfma(af1[mi], bf1[ni], acc[mi][ni]);
    __builtin_amdgcn_sched_barrier(0);
    PLAINBAR();
    cur += STAGE; if (cur >= 4 * STAGE) cur -= 4 * STAGE;
  }
  if (wr == 0) PLAINBAR();
#undef FRAG_READ
#undef PLAINBAR
#undef DMA_TILE
#undef DMA_NEXT
}

template <int MI>
DEVI void zero_acc(f32x16 (&acc)[MI][2]) {
#pragma unroll
  for (int a = 0; a < MI; ++a)
#pragma unroll
    for (int b = 0; b < 2; ++b)
#pragma unroll
      for (int r = 0; r < 16; ++r) acc[a][b][r] = 0.f;
}

DEVI void acc_to_lds(const f32x16 (&acc)[2][2], lchar* lds) {
  const int tid = otid(), lane = tid & 63, wave = tid >> 6, wr = wave >> 2, wc = wave & 3, l32 = lane & 31, g = lane >> 5;
  LAS float* Cs = (LAS float*)lds;
#pragma unroll
  for (int mi = 0; mi < 2; ++mi)
#pragma unroll
    for (int ni = 0; ni < 2; ++ni)
#pragma unroll
      for (int r = 0; r < 16; ++r) Cs[(wr * 64 + mi * 32 + crow(r, g)) * CP + wc * 64 + ni * 32 + l32] = acc[mi][ni][r];
}
DEVI void acc_to_lds_half(const f32x16 (&acc)[4][2], lchar* lds, int hf, int rowofs) {
  const int tid = otid(), lane = tid & 63, wave = __builtin_amdgcn_readfirstlane(tid >> 6), wr = wave >> 2, wc = wave & 3, l32 = lane & 31, g = lane >> 5;
  LAS float* Cs = (LAS float*)lds;
  if (wr == hf) {
#pragma unroll
    for (int mi = 0; mi < 4; ++mi)
#pragma unroll
      for (int ni = 0; ni < 2; ++ni)
#pragma unroll
        for (int r = 0; r < 16; ++r) Cs[(rowofs + mi * 32 + crow(r, g)) * CP + wc * 64 + ni * 32 + l32] = acc[mi][ni][r];
  }
}

DEVI int xsched_idx(int i) { const int ns = gridDim.x >> 3; return (i * 8 + (int)(blockIdx.x & 7)) * ns + (int)(blockIdx.x >> 3); }
DEVI bool gemm_tile(int idx, int MT, int NT, int& mt, int& nt) { const int mg = idx / (4 * NT), rem = idx - mg * 4 * NT; nt = rem >> 2; mt = mg * 4 + (rem & 3); return mt < MT; }

DEVI void transpose_item(const float* __restrict__ W, int K, int N, bf16* __restrict__ Wt, int item, lchar* lds) {
  const int nnb = N >> 6, kb = item / nnb, nb = item - kb * nnb, tid = otid();
  LAS float* t = (LAS float*)lds;
  __syncthreads();
#pragma unroll
  for (int i = 0; i < 8; ++i) { const int k = (tid >> 6) + 8 * i, n = tid & 63; t[k * 65 + n] = W[(size_t)(kb * 64 + k) * N + nb * 64 + n]; }
  __syncthreads();
  {
    const int n = tid >> 3, kc = tid & 7;
    float v[8];
#pragma unroll
    for (int j = 0; j < 8; ++j) v[j] = t[(kc * 8 + j) * 65 + n];
    u32x4 o; o.x = cvtpk(v[0], v[1]); o.y = cvtpk(v[2], v[3]); o.z = cvtpk(v[4], v[5]); o.w = cvtpk(v[6], v[7]);
    *(u32x4*)(Wt + (size_t)(nb * 64 + n) * K + kb * 64 + kc * 8) = o;
  }
}

DEVI void phase_weights(const Params& p, lchar* lds) {
  constexpr int I_IN = 16 * 108, I_B = 4 * 16, I_OUT = 16 * 16, I_UP = 16 * 88, I_DN = 44 * 16;
  constexpr int T_IN = 2 * I_IN, T_B = 8 * I_B, T_OUT = 2 * I_OUT, T_UP = 2 * I_UP, T_DN = 2 * I_DN;
  constexpr int TOTAL = T_IN + T_B + T_OUT + T_UP + T_DN;
  for (int it = blockIdx.x; it < TOTAL; it += gridDim.x) {
    int r = it;
    if (r < T_IN) { const int l = r / I_IN; transpose_item(p.w_in + (size_t)l * DM * INC, DM, INC, (bf16*)(p.ws + WS_WIN) + (size_t)l * INC * DM, r - l * I_IN, lds); continue; }
    r -= T_IN;
    if (r < T_B) { const int lb = r / I_B; transpose_item(p.w_branch + (size_t)lb * 256 * DM, 256, DM, (bf16*)(p.ws + WS_WB) + (size_t)lb * DM * 256, r - lb * I_B, lds); continue; }
    r -= T_B;
    if (r < T_OUT) { const int l = r / I_OUT; transpose_item(p.w_out + (size_t)l * DM * DM, DM, DM, (bf16*)(p.ws + WS_WOUT) + (size_t)l * DM * DM, r - l * I_OUT, lds); continue; }
    r -= T_OUT;
    if (r < T_UP) { const int l = r / I_UP; transpose_item(p.w_up + (size_t)l * DM * NUP, DM, NUP, (bf16*)(p.ws + WS_WUP) + (size_t)l * NUP * DM, r - l * I_UP, lds); continue; }
    r -= T_UP;
    { const int l = r / I_DN; transpose_item(p.w_down + (size_t)l * DFF * DM, DFF, DM, (bf16*)(p.ws + WS_WDN) + (size_t)l * DM * DFF, r - l * I_DN, lds); }
  }
}

DEVI void phase_norm(const Params& p, int mode, const float* __restrict__ gain) {
  const int lane = otid() & 63, gw = blockIdx.x * 8 + (otid() >> 6), ngw = gridDim.x * 8;
  bf16* H = (bf16*)(p.ws + WS_H);
  f32x4 gg[4];
#pragma unroll
  for (int j = 0; j < 4; ++j) gg[j] = ((const f32x4*)gain)[lane + 64 * j];
  for (int row0 = gw; row0 < MTOK / 2; row0 += ngw) {
    f32x4 v[2][4]; float ss[2];
#pragma unroll
    for (int u = 0; u < 2; ++u) {
      const int row = row0 + u * (MTOK / 2);
      const float* src = (mode == 0) ? (row < 2 * SEQ ? p.xp + (size_t)row * DM : p.xs + (size_t)(row - 2 * SEQ) * DM) : p.out + (size_t)row * DM;
#pragma unroll
      for (int j = 0; j < 4; ++j) v[u][j] = ((const f32x4*)src)[lane + 64 * j];
    }
#pragma unroll
    for (int u = 0; u < 2; ++u) {
      float s = 0.f;
#pragma unroll
      for (int j = 0; j < 4; ++j) s += (v[u][j].x * v[u][j].x + v[u][j].y * v[u][j].y) + (v[u][j].z * v[u][j].z + v[u][j].w * v[u][j].w);
      ss[u] = wave_sum(s);
    }
#pragma unroll
    for (int u = 0; u < 2; ++u) {
      const int row = row0 + u * (MTOK / 2);
      const float rstd = 1.0f / sqrtf(ss[u] * (1.0f / DM) + EPS);
      float* orow = p.out + (size_t)row * DM;
#pragma unroll
      for (int j = 0; j < 4; ++j) {
        const f32x4 y = v[u][j] * rstd * gg[j];
        if (mode == 2) ((f32x4*)orow)[lane + 64 * j] = y;
        else { u32x2 w; w.x = cvtpk(y.x, y.y); w.y = cvtpk(y.z, y.w); ((u32x2*)(H + (size_t)row * DM))[lane + 64 * j] = w; }
      }
    }
  }
}

DEVI void rot(float& a, float& b, double t) {
  const float rv = (float)(t - __builtin_rint(t));
  const float cs = __builtin_amdgcn_cosf(rv), sn = __builtin_amdgcn_sinf(rv);
  const float x1 = a, x2 = b; a = x1 * cs - x2 * sn; b = x2 * cs + x1 * sn;
}

DEVI void phase_qkv(const Params& p, int layer, lchar* lds) {
  const bf16* H = (const bf16*)(p.ws + WS_H);
  const bf16* Wt = (const bf16*)(p.ws + WS_WIN) + (size_t)layer * INC * DM;
  bf16* QKV = (bf16*)(p.ws + WS_QKV);
  const int tid = otid();
  constexpr int NT = 11, MT = MTOK / 256, TILES = MT * NT;
  for (int i = 0;; ++i) {
    const int idx = xsched_idx(i); if (idx >= TILES) break;
    int mt, nt; gemm_tile(idx, MT, NT, mt, nt);
    const int n0 = nt * 256;
    f32x16 acc[4][2]; zero_acc<4>(acc);
    gemm_dma<4>(acc, lds, H, DM, mt * 256, 0, MTOK - 1, Wt, DM, n0, n0 + 128, DM);
    {
      const int lane = tid & 63, wave = __builtin_amdgcn_readfirstlane(tid >> 6), wr = wave >> 2, wc = wave & 3, l32 = lane & 31, g = lane >> 5;
      LAS float* Wp = (LAS float*)(lds + wave * 17408);
      const int G = nt * 4 + wc;
      const float qs = 0.125f * LOG2E;
      const bool isD = (G >= 36 && G < 42);
#pragma unroll
      for (int c2 = 0; c2 < 2; ++c2) {
#pragma unroll
        for (int mi = 0; mi < 2; ++mi)
#pragma unroll
          for (int ni = 0; ni < 2; ++ni)
#pragma unroll
            for (int r = 0; r < 16; ++r) Wp[(mi * 32 + crow(r, g)) * 68 + ni * 32 + l32] = acc[2 * c2 + mi][ni][r];
        asm volatile("s_waitcnt lgkmcnt(0)" ::: "memory");
        const int grow = mt * 256 + wr * 128 + c2 * 64 + lane, pos = grow & (SEQ - 1);
        const LAS float* rowp = Wp + lane * 68;
        float rstd = 1.f;
        if (isD) {
          float ss = 0.f;
#pragma unroll
          for (int i = 0; i < 16; ++i) { const f32x4 t = *(const LAS f32x4*)(rowp + 4 * i); ss += (t.x * t.x + t.y * t.y) + (t.z * t.z + t.w * t.w); }
          rstd = 1.0f / sqrtf(ss * (1.0f / 64.0f) + EPS);
        }
        bf16* dst = QKV + (size_t)grow * NQKV + G * 64;
#pragma unroll 1
        for (int hh = 0; hh < 2; ++hh) {
          float v[32];
#pragma unroll
          for (int i = 0; i < 8; ++i) { const f32x4 t = *(const LAS f32x4*)(rowp + hh * 32 + 4 * i); v[4 * i] = t.x; v[4 * i + 1] = t.y; v[4 * i + 2] = t.z; v[4 * i + 3] = t.w; }
          float sc = 1.f;
          if (G < 8) {
#pragma unroll
            for (int i = 0; i < 4; ++i) rot(v[i], v[4 + i], (double)pos * p.invA[i]);
            if (G < 4) sc = 0.17677669529663687f * LOG2E;
          } else if (G >= 12 && G < 16) { sc = qs;
          } else if (G >= 24 && G < 32) {
            if (hh == 0) {
#pragma unroll
              for (int i = 0; i < 8; ++i) rot(v[i], v[8 + i], (double)pos * p.invC[i]);
            }
            if (G < 28) sc = qs;
          } else if (isD) {
            const float* gq = p.qk_norm + layer * 128 + (G < 40 ? 0 : 64) + hh * 32;
#pragma unroll
            for (int i = 0; i < 32; ++i) v[i] = v[i] * rstd * gq[i];
            const int pa = hh == 0 ? (pos >> 6) : (pos & 63);
#pragma unroll
            for (int i = 0; i < 16; ++i) rot(v[i], v[16 + i], (double)pa * p.invD[i]);
            if (G < 40) sc = qs;
          }
#pragma unroll
          for (int i = 0; i < 4; ++i) {
            u32x4 o; o.x = cvtpk(v[8 * i] * sc, v[8 * i + 1] * sc); o.y = cvtpk(v[8 * i + 2] * sc, v[8 * i + 3] * sc);
            o.z = cvtpk(v[8 * i + 4] * sc, v[8 * i + 5] * sc); o.w = cvtpk(v[8 * i + 6] * sc, v[8 * i + 7] * sc);
            ((u32x4*)(dst + hh * 32))[i] = o;
          }
        }
        asm volatile("s_waitcnt lgkmcnt(0)" ::: "memory");
      }
    }
    __syncthreads();
  }
}

struct FState { float m; bool init; f32x16 negm; f32x16 o[2]; f32x16 ls; };
DEVI void fstate_init(FState& st) {
  st.m = 0.f; st.init = false;
#pragma unroll
  for (int r = 0; r < 16; ++r) { st.negm[r] = 0.f; st.o[0][r] = 0.f; st.o[1][r] = 0.f; st.ls[r] = 0.f; }
}
template <int NKH>
DEVI void flash_update(f32x16 (&s)[NKH], FState& st, const lchar* vb, int dhs, int lane) {
  float mx = s[0][0];
#pragma unroll
  for (int kh = 0; kh < NKH; ++kh)
#pragma unroll
    for (int r = 0; r < 16; ++r) mx = fmaxf(mx, s[kh][r]);
  mx = fmaxf(mx, __shfl_xor(mx, 32));
  const bool fin = mx > -1e30f;
  const bool upd = (mx > 8.0f) || (!st.init && fin);
  st.init = st.init || fin;
  if (__any(upd)) {
    const float d = upd ? mx : 0.f;
    st.m += d;
    const float alpha = ex2(-d);
#pragma unroll
    for (int dh = 0; dh < 2; ++dh)
#pragma unroll
      for (int r = 0; r < 16; ++r) st.o[dh][r] *= alpha;
#pragma unroll
    for (int r = 0; r < 16; ++r) st.ls[r] *= alpha;
#pragma unroll
    for (int kh = 0; kh < NKH; ++kh)
#pragma unroll
      for (int r = 0; r < 16; ++r) s[kh][r] -= d;
    const float nm = -st.m;
#pragma unroll
    for (int r = 0; r < 16; ++r) st.negm[r] = nm;
  }
#pragma unroll
  for (int kh = 0; kh < NKH; ++kh)
#pragma unroll
    for (int r = 0; r < 16; ++r) s[kh][r] = ex2(s[kh][r]);
  const int g = lane >> 5;
  const lchar* vp = vb + (4 * g + ((lane & 15) >> 2)) * 64 + ((lane >> 4) & 1) * 32 + (lane & 3) * 8;
  const bf16x8 ones = {0x3f80, 0x3f80, 0x3f80, 0x3f80, 0x3f80, 0x3f80, 0x3f80, 0x3f80};
#pragma unroll
  for (int kh = 0; kh < NKH; ++kh)
#pragma unroll
    for (int j = 0; j < 2; ++j) {
      u32x4 pw; pw.x = cvtpk(s[kh][8 * j], s[kh][8 * j + 1]); pw.y = cvtpk(s[kh][8 * j + 2], s[kh][8 * j + 3]);
      pw.z = cvtpk(s[kh][8 * j + 4], s[kh][8 * j + 5]); pw.w = cvtpk(s[kh][8 * j + 6], s[kh][8 * j + 7]);
      const bf16x8 pb = __builtin_bit_cast(bf16x8, pw);
#pragma unroll
      for (int dh = 0; dh < 2; ++dh) {
        const s16x4 lo = trread(vp + dh * dhs + (kh * 32 + 16 * j) * 64), hi = trread(vp + dh * dhs + (kh * 32 + 16 * j + 8) * 64);
        const bf16x8 a = {lo[0], lo[1], lo[2], lo[3], hi[0], hi[1], hi[2], hi[3]};
        st.o[dh] = mfma(a, pb, st.o[dh]);
      }
      st.ls = mfma(ones, pb, st.ls);
    }
}

DEVI void write_o(const f32x16 (&o)[2], float sc, bf16* dst, int g) {
#pragma unroll
  for (int dh = 0; dh < 2; ++dh)
#pragma unroll
    for (int r4 = 0; r4 < 4; ++r4) {
      u32x2 w; w.x = cvtpk(o[dh][4 * r4] * sc, o[dh][4 * r4 + 1] * sc); w.y = cvtpk(o[dh][4 * r4 + 2] * sc, o[dh][4 * r4 + 3] * sc);
      *(u32x2*)(dst + 32 * dh + 8 * r4 + 4 * g) = w;
    }
}

constexpr int AT_BUF = 17408, AT_V = 9216;

struct KVRegs { u32x4 k, v; };
DEVI void kv_load(KVRegs& r, const bf16* __restrict__ Kp, const bf16* __restrict__ Vp, int tok0, int tid) {
  const int row = tid >> 3, ch = tid & 7;
  r.k = *(const u32x4*)(Kp + (size_t)(tok0 + row) * NQKV + ch * 8);
  r.v = *(const u32x4*)(Vp + (size_t)(tok0 + row) * NQKV + ch * 8);
}
DEVI void kv_store(const KVRegs& r, lchar* buf, int tid) {
  const int row = tid >> 3, ch = tid & 7;
  *(LAS u32x4*)(buf + row * 144 + ch * 16) = r.k;
  *(LAS u32x4*)(buf + AT_V + (ch >> 2) * 4096 + row * 64 + (ch & 3) * 16) = r.v;
}

template <int NKS>
DEVI void attn_full_loop(const bf16* __restrict__ QKV, int seqbase, int tokq, int qcol, int kcol, int vcol, int kdimofs, FState& st, lchar* lds) {
  const int tid = otid(), lane = tid & 63, l32 = lane & 31, g = lane >> 5;
  bf16x8 qf[NKS];
#pragma unroll
  for (int ks = 0; ks < NKS; ++ks) qf[ks] = *(const bf16x8*)(QKV + (size_t)tokq * NQKV + qcol + 16 * ks + 8 * g);
  const bf16* Kp = QKV + kcol;
  const bf16* Vp = QKV + vcol;
  KVRegs kra[2], krb[2];
  __syncthreads();
#define KV_LOAD2(R, tok) do { kv_load(R[0], Kp, Vp, (tok), tid); kv_load(R[1], Kp, Vp, (tok) + 64, tid); } while (0)
#define KV_STORE2(R, base) do { kv_store(R[0], (base), tid); kv_store(R[1], (base) + AT_BUF, tid); } while (0)
  KV_LOAD2(kra, seqbase);
  KV_LOAD2(krb, seqbase + 128);
  KV_STORE2(kra, lds);
  __syncthreads();
  constexpr int NT2 = SEQ / 128;
#define ATT_TILE(buf) do { f32x16 s[2]; \
    _Pragma("unroll") for (int kh = 0; kh < 2; ++kh) { _Pragma("unroll") for (int ks = 0; ks < NKS; ++ks) { \
      const bf16x8 a_ = *(const LAS bf16x8*)((buf) + (kh * 32 + l32) * 144 + kdimofs + ks * 32 + g * 16); \
      s[kh] = mfma(a_, qf[ks], ks == 0 ? st.negm : s[kh]); } } \
    flash_update<2>(s, st, (buf) + AT_V, 4096, lane); } while (0)
  for (int t = 0; t < NT2; t += 2) {
    if (t + 2 < NT2) KV_LOAD2(kra, seqbase + (t + 2) * 128);
    ATT_TILE(lds);
    ATT_TILE(lds + AT_BUF);
    KV_STORE2(krb, lds + 2 * AT_BUF);
    __syncthreads();
    if (t + 3 < NT2) KV_LOAD2(krb, seqbase + (t + 3) * 128);
    ATT_TILE(lds + 2 * AT_BUF);
    ATT_TILE(lds + 3 * AT_BUF);
    if (t + 2 < NT2) KV_STORE2(kra, lds);
    __syncthreads();
  }
#undef ATT_TILE
#undef KV_LOAD2
#undef KV_STORE2
}

DEVI void attn_A(const Params& p, int layer, int it, lchar* lds) {
  const int seq = it >> 8, h = (it >> 6) & 3, qb = it & 63;
  const int tid = otid(), lane = tid & 63, wave = tid >> 6, l32 = lane & 31, g = lane >> 5;
  const int c = wave & 1, qh = wave >> 1;
  const bf16* QKV = (const bf16*)(p.ws + WS_QKV);
  bf16* O = (bf16*)(p.ws + WS_O);
  const int tokq = seq * SEQ + qb * 128 + qh * 32 + l32;
  FState st; fstate_init(st);
  attn_full_loop<2>(QKV, seq * SEQ, tokq, 64 * h + 32 * c, 256 + 64 * h, 512 + 64 * h, 64 * c, st, lds);
  f32x16 (&o)[2] = st.o;
  const float* lv = p.diff_lambda + layer * 128;
  float d1 = 0.f, d2 = 0.f;
#pragma unroll
  for (int i = 0; i < 32; ++i) { d1 += lv[i] * lv[32 + i]; d2 += lv[64 + i] * lv[96 + i]; }
  const float lam_init = p.lam_init[layer];
  const float lam = expf(d1) - expf(d2) + lam_init;
  const float lt = st.ls[0];
  const float sc = (c == 0) ? 1.0f / lt : lam / lt;
  LAS float* xb = (LAS float*)lds + qh * 2048;
  if (c == 1) {
#pragma unroll
    for (int dh = 0; dh < 2; ++dh)
#pragma unroll
      for (int r = 0; r < 16; ++r) xb[(dh * 16 + r) * 64 + lane] = o[dh][r] * sc;
  }
  __syncthreads();
  if (c == 0) {
    float ss = 0.f;
#pragma unroll
    for (int dh = 0; dh < 2; ++dh)
#pragma unroll
      for (int r = 0; r < 16; ++r) { const float x = o[dh][r] * sc - xb[(dh * 16 + r) * 64 + lane]; o[dh][r] = x; ss += x * x; }
    ss += __shfl_xor(ss, 32);
    const float rstd = (1.0f - lam_init) / sqrtf(ss * (1.0f / 64.0f) + EPS);
    const float* sg = p.diff_subln + layer * 64;
#pragma unroll
    for (int dh = 0; dh < 2; ++dh)
#pragma unroll
      for (int r = 0; r < 16; ++r) o[dh][r] *= sg[32 * dh + crow(r, g)];
    write_o(o, rstd, O + (size_t)tokq * DM + 64 * h, g);
  }
}

DEVI void attn_D(const Params& p, int it, lchar* lds) {
  const int seq = it >> 7, kv = (it >> 6) & 1, qb = it & 63;
  const int tid = otid(), lane = tid & 63, wave = tid >> 6, l32 = lane & 31, g = lane >> 5;
  const bf16* QKV = (const bf16*)(p.ws + WS_QKV);
  bf16* O = (bf16*)(p.ws + WS_O);
  const int hq = 2 * kv + (wave & 1);
  const int tokq = seq * SEQ + qb * 128 + (wave >> 1) * 32 + l32;
  FState st; fstate_init(st);
  attn_full_loop<4>(QKV, seq * SEQ, tokq, 2304 + 64 * hq, 2560 + 64 * kv, 2688 + 64 * kv, 0, st, lds);
  const float lt = st.ls[0];
  write_o(st.o, 1.0f / lt, O + (size_t)tokq * DM + 768 + 64 * hq, g);
}

constexpr int ATB_BIAS = 8 * AT_BUF;
struct KVRegs4 { u32x4 k[4], v[4]; };
DEVI void kvb_load(KVRegs4& r, const bf16* __restrict__ QKV, int tok0, int tid) {
  const int hd = tid >> 7, t7 = tid & 127;
#pragma unroll
  for (int i = 0; i < 4; ++i) {
    const int c = t7 + 128 * i, row = c >> 3, ch = c & 7;
    r.k[i] = *(const u32x4*)(QKV + (size_t)(tok0 + row) * NQKV + 1024 + 64 * hd + ch * 8);
    r.v[i] = *(const u32x4*)(QKV + (size_t)(tok0 + row) * NQKV + 1280 + 64 * hd + ch * 8);
  }
}
DEVI void kvb_store(const KVRegs4& r, lchar* lds, int bufsel, int tid) {
  const int hd = tid >> 7, t7 = tid & 127;
  lchar* buf = lds + (hd * 2 + bufsel) * AT_BUF;
#pragma unroll
  for (int i = 0; i < 4; ++i) {
    const int c = t7 + 128 * i, row = c >> 3, ch = c & 7;
    *(LAS u32x4*)(buf + row * 144 + ch * 16) = r.k[i];
    *(LAS u32x4*)(buf + AT_V + (ch >> 2) * 4096 + row * 64 + (ch & 3) * 16) = r.v[i];
  }
}
DEVI void attn_B(const Params& p, int layer, int it, lchar* lds) {
  const int seq = it >> 7, r = it & 127;
  const int tid = otid(), lane = tid & 63, wave = tid >> 6, l32 = lane & 31, g = lane >> 5;
  const int h = wave >> 1;
  const bf16* QKV = (const bf16*)(p.ws + WS_QKV);
  bf16* O = (bf16*)(p.ws + WS_O);
  const int qc = (wave & 1) * 32 + l32;
  const int tokq = seq * SEQ + r * 64 + qc;
  bf16x8 qf[4];
#pragma unroll
  for (int ks = 0; ks < 4; ++ks) qf[ks] = *(const bf16x8*)(QKV + (size_t)tokq * NQKV + 768 + 64 * h + 16 * ks + 8 * g);
  int rs = r - 4; rs = rs < 0 ? 0 : (rs > 120 ? 120 : rs);
  const int tokk = seq * SEQ + rs * 64;
  LAS float* bias = (LAS float*)(lds + ATB_BIAS) + h * 465;
  const float* rpb = p.na_rpb + (size_t)(layer * 4) * 465;
  FState st; fstate_init(st);
  int cs = qc - 8; cs = cs < 0 ? 0 : (cs > 48 ? 48 : cs);
  __syncthreads();
  for (int i = tid; i < 4 * 465; i += NTHR) ((LAS float*)(lds + ATB_BIAS))[i] = rpb[i] * LOG2E;
  for (int t = 0; t < 8; ++t) {
    { KVRegs4 kr; kvb_load(kr, QKV, tokk + t * 64, tid); kvb_store(kr, lds, t & 1, tid); }
    __syncthreads();
    lchar* buf = lds + (h * 2 + (t & 1)) * AT_BUF;
    const int dr = rs + t - r + 7;
    f32x16 s[2];
#pragma unroll
    for (int kh = 0; kh < 2; ++kh) {
#pragma unroll
      for (int ks = 0; ks < 4; ++ks) {
        const bf16x8 a = *(const LAS bf16x8*)(buf + (kh * 32 + l32) * 144 + ks * 32 + g * 16);
        s[kh] = mfma(a, qf[ks], ks == 0 ? st.negm : s[kh]);
      }
#pragma unroll
      for (int rr = 0; rr < 16; ++rr) {
        const int kc = kh * 32 + crow(rr, g);
        int dc = kc - qc + 15; dc = dc < 0 ? 0 : (dc > 30 ? 30 : dc);
        const bool valid = (kc >= cs) && (kc < cs + 16);
        s[kh][rr] = valid ? s[kh][rr] + bias[dr * 31 + dc] : -INFINITY;
      }
    }
    flash_update<2>(s, st, buf + AT_V, 4096, lane);
  }
  const float lt = st.ls[0];
  write_o(st.o, 1.0f / lt, O + (size_t)tokq * DM + 256 + 64 * h, g);
}

constexpr int CW_BUF = 8704, CW_V = 4608;
struct CRegs { u32x4 k[4], v[4]; };
DEVI void c_tile_params(int tg, int& st, int& j0) {
  if (tg < 5) { st = 16; j0 = -64 + 32 * tg; }
  else if (tg < 13) { st = 4; j0 = -64 + 32 * (tg - 5); }
  else { st = 1; j0 = -64 + 32 * (tg - 13); }
}
DEVI void c_load(CRegs& r, const bf16* __restrict__ Kp, const bf16* __restrict__ Vp, int seqbase, int qp0, int tg, int lane) {
  int st, j0; c_tile_params(tg, st, j0);
#pragma unroll
  for (int i = 0; i < 4; ++i) {
    const int c = lane + 64 * i, row = c >> 3, ch = c & 7;
    int kp = qp0 + st * (j0 + row); kp = kp < 0 ? 0 : (kp > SEQ - 1 ? SEQ - 1 : kp);
    r.k[i] = *(const u32x4*)(Kp + (size_t)(seqbase + kp) * NQKV + ch * 8);
    r.v[i] = *(const u32x4*)(Vp + (size_t)(seqbase + kp) * NQKV + ch * 8);
  }
}
DEVI void c_store(const CRegs& r, lchar* wb, int lane) {
#pragma unroll
  for (int i = 0; i < 4; ++i) {
    const int c = lane + 64 * i, row = c >> 3, ch = c & 7;
    *(LAS u32x4*)(wb + row * 144 + ch * 16) = r.k[i];
    *(LAS u32x4*)(wb + CW_V + (ch >> 2) * 2048 + row * 64 + (ch & 3) * 16) = r.v[i];
  }
}
DEVI void attn_C(const Params& p, int it, lchar* lds) {
  const int seq = it >> 7, h = (it >> 5) & 3, span = (it >> 1) & 15, half = it & 1;
  const int tid = otid(), lane = tid & 63, wave = tid >> 6, l32 = lane & 31, g = lane >> 5;
  const bf16* QKV = (const bf16*)(p.ws + WS_QKV);
  bf16* O = (bf16*)(p.ws + WS_O);
  const int rho = half * 8 + wave, qp0 = span * 512 + rho;
  const int seqbase = seq * SEQ;
  const int tokq = seqbase + qp0 + 16 * l32;
  bf16x8 qf[4];
#pragma unroll
  for (int ks = 0; ks < 4; ++ks) qf[ks] = *(const bf16x8*)(QKV + (size_t)tokq * NQKV + 1536 + 64 * h + 16 * ks + 8 * g);
  const bf16* Kp = QKV + 1792 + 64 * h;
  const bf16* Vp = QKV + 2048 + 64 * h;
  lchar* wb = lds + wave * CW_BUF;
  FState fs; fstate_init(fs);
  CRegs cr;
  c_load(cr, Kp, Vp, seqbase, qp0, 0, lane);
  __syncthreads();
  for (int tg = 0; tg < 33; ++tg) {
    asm volatile("" ::: "memory");
    c_store(cr, wb, lane);
    asm volatile("s_waitcnt lgkmcnt(0)" ::: "memory");
    if (tg + 1 < 33) c_load(cr, Kp, Vp, seqbase, qp0, tg + 1, lane);
    int st, j0; c_tile_params(tg, st, j0);
    f32x16 s[1];
#pragma unroll
    for (int ks = 0; ks < 4; ++ks) {
      const bf16x8 a = *(const LAS bf16x8*)(wb + l32 * 144 + ks * 32 + g * 16);
      s[0] = mfma(a, qf[ks], ks == 0 ? fs.negm : s[0]);
    }
#pragma unroll
    for (int rr = 0; rr < 16; ++rr) {
      const int jj = j0 + crow(rr, g);
      const int kp = qp0 + st * jj;
      int dd = 16 * l32 - st * jj; dd = dd < 0 ? -dd : dd;
      const bool valid = (dd <= 64 * st) && (kp >= 0) && (kp < SEQ);
      s[0][rr] = valid ? s[0][rr] : -INFINITY;
    }
    flash_update<1>(s, fs, wb + CW_V, 2048, lane);
  }
  const float lt = fs.ls[0];
  write_o(fs.o, 1.0f / lt, O + (size_t)tokq * DM + 512 + 64 * h, g);
}

DEVI void phase_attn(const Params& p, int layer, lchar* lds) {
  constexpr int NA = NSEQ * 4 * 64, ND = NSEQ * 2 * 64, NB = NSEQ * 128, NC = NSEQ * 4 * 16 * 2;
  for (int i = 0;; ++i) {
    const int it = xsched_idx(i); if (it >= NA + ND + NB + NC) break;
    if (it < NA) attn_A(p, layer, it, lds);
    else if (it < NA + ND) attn_D(p, it - NA, lds);
    else if (it < NA + ND + NB) attn_B(p, layer, it - NA - ND, lds);
    else attn_C(p, it - NA - ND - NB, lds);
    __syncthreads();
  }
}

DEVI void phase_merge(const Params& p, int layer, lchar* lds) {
  const bf16* H = (const bf16*)(p.ws + WS_H);
  const bf16* Ob = (const bf16*)(p.ws + WS_O);
  const bf16* Wt = (const bf16*)(p.ws + WS_WIN) + (size_t)layer * INC * DM;
  const bf16* Wb = (const bf16*)(p.ws + WS_WB) + (size_t)layer * 4 * DM * 256;
  bf16* MG = (bf16*)(p.ws + WS_QKV);
  constexpr int NT = 4, MT = MTOK / 128, TILES = MT * NT;
  for (int i = 0;; ++i) {
    const int idx = xsched_idx(i); if (idx >= TILES) break;
    const int tid = otid();
    int mt, nt; gemm_tile(idx, MT, NT, mt, nt);
    const int m0 = mt * 128, n0 = nt * 256;
    unsigned mgp[2][2][8];
#pragma unroll
    for (int mi = 0; mi < 2; ++mi)
#pragma unroll
      for (int ni = 0; ni < 2; ++ni)
#pragma unroll
        for (int j = 0; j < 8; ++j) mgp[mi][ni][j] = 0u;
    for (int b = 0; b < 4; ++b) {
      f32x16 acc[2][2]; zero_acc<2>(acc);
      const int gr = NQKV + b * DM + n0;
      gemm_dma<2, true>(acc, lds, H, DM, m0, 0, MTOK - 1, Wt, DM, gr, gr + 128, DM,
                        b > 0, Ob + 256 * b, DM, Wb + (size_t)b * DM * 256, 256, n0, n0 + 128);
      unsigned sg[2][2][8];
#pragma unroll
      for (int mi = 0; mi < 2; ++mi)
#pragma unroll
        for (int ni = 0; ni < 2; ++ni)
#pragma unroll
          for (int j = 0; j < 8; ++j) {
            const float s0 = __builtin_amdgcn_rcpf(1.0f + ex2(-acc[mi][ni][2 * j] * LOG2E));
            const float s1 = __builtin_amdgcn_rcpf(1.0f + ex2(-acc[mi][ni][2 * j + 1] * LOG2E));
            sg[mi][ni][j] = cvtpk(s0, s1);
          }
      zero_acc<2>(acc);
      gemm_dma<2, true>(acc, lds, Ob + 256 * b, DM, m0, 0, MTOK - 1, Wb + (size_t)b * DM * 256, 256, n0, n0 + 128, 256,
                        true, b < 3 ? H : nullptr, DM, Wt, DM, gr + DM, gr + DM + 128);
#pragma unroll
      for (int mi = 0; mi < 2; ++mi)
#pragma unroll
        for (int ni = 0; ni < 2; ++ni)
#pragma unroll
          for (int j = 0; j < 8; ++j) {
            const unsigned w = sg[mi][ni][j], mo = mgp[mi][ni][j];
            const float lo = __uint_as_float(mo << 16) + __uint_as_float(w << 16) * acc[mi][ni][2 * j];
            const float hi = __uint_as_float(mo & 0xffff0000u) + __uint_as_float(w & 0xffff0000u) * acc[mi][ni][2 * j + 1];
            mgp[mi][ni][j] = cvtpk(lo, hi);
          }
    }
    f32x16 mg[2][2];
#pragma unroll
    for (int mi = 0; mi < 2; ++mi)
#pragma unroll
      for (int ni = 0; ni < 2; ++ni)
#pragma unroll
        for (int j = 0; j < 8; ++j) { mg[mi][ni][2 * j] = __uint_as_float(mgp[mi][ni][j] << 16); mg[mi][ni][2 * j + 1] = __uint_as_float(mgp[mi][ni][j] & 0xffff0000u); }
    acc_to_lds(mg, lds);
    __syncthreads();
    {
      const LAS float* Cs = (const LAS float*)lds;
#pragma unroll
      for (int k = 0; k < 8; ++k) {
        const int id = tid + 512 * k, row = id >> 5, ch = id & 31;
        const f32x4 a = *(const LAS f32x4*)(Cs + row * CP + ch * 8), b2 = *(const LAS f32x4*)(Cs + row * CP + ch * 8 + 4);
        u32x4 o; o.x = cvtpk(a.x, a.y); o.y = cvtpk(a.z, a.w); o.z = cvtpk(b2.x, b2.y); o.w = cvtpk(b2.z, b2.w);
        *(u32x4*)(MG + (size_t)(m0 + row) * DM + n0 + ch * 8) = o;
      }
    }
    __syncthreads();
  }
}

DEVI void phase_resid(const Params& p, float* xout, const bf16* A, int lda, const bf16* Wt, int K, lchar* lds, bool from_inputs) {
  const int tid = otid();
  constexpr int NT = 4, MT = MTOK / 256, TILES = MT * NT;
  for (int i = 0;; ++i) {
    const int idx = xsched_idx(i); if (idx >= TILES) break;
    int mt, nt; gemm_tile(idx, MT, NT, mt, nt);
    const int n0 = nt * 256;
    f32x16 acc[4][2]; zero_acc<4>(acc);
    gemm_dma<4>(acc, lds, A, lda, mt * 256, 0, MTOK - 1, Wt, K, n0, n0 + 128, K);
    for (int hf = 0; hf < 2; ++hf) {
      const int m0 = mt * 256 + hf * 128;
      acc_to_lds_half(acc, lds, hf, 0);
      __syncthreads();
      const LAS float* Cs = (const LAS float*)lds;
#pragma unroll
      for (int k = 0; k < 16; ++k) {
        const int id = tid + 512 * k, row = id >> 6, c4 = id & 63;
        const f32x4 a = *(const LAS f32x4*)(Cs + row * CP + c4 * 4);
        const int grow = m0 + row;
        f32x4* xp = (f32x4*)(xout + (size_t)grow * DM + n0 + c4 * 4);
        const float* xsrc = !from_inputs ? (const float*)xp : (grow < 2 * SEQ ? p.xp + (size_t)grow * DM : p.xs + (size_t)(grow - 2 * SEQ) * DM) + n0 + c4 * 4;
        *xp = *(const f32x4*)xsrc + a;
      }
      __syncthreads();
    }
  }
}

DEVI float gelu_exact(float v) {
  const float av = fabsf(v), t = __builtin_amdgcn_rcpf(av * 0.2316418882f + 1.0f);
  float q = t * 0.5307027145f + (-0.7265760135f); q = q * t + 0.7107068705f; q = q * t + (-0.142248368f); q = q * t + 0.127414796f; q = q * t;
  const float e = ex2((v * v) * (-0.72134752044f));
  const float mm = v * (q * e);
  return v < 0.f ? mm : v - mm;
}
DEVI void phase_up(const Params& p, int layer, lchar* lds) {
  const bf16* H = (const bf16*)(p.ws + WS_H);
  const bf16* Wt = (const bf16*)(p.ws + WS_WUP) + (size_t)layer * NUP * DM;
  bf16* ACT = (bf16*)(p.ws + WS_QKV);
  const float* cw = p.conv_w + (size_t)layer * 3 * NUP;
  const float* cb = p.conv_b + (size_t)layer * NUP;
  const int tid = otid(), lane = tid & 63, wave = __builtin_amdgcn_readfirstlane(tid >> 6), wr = wave >> 2, wc = wave & 3, l32 = lane & 31, g = lane >> 5;
  constexpr int MT = 33, NT = 22, SMT = NSEQ * MT, TILES = ((SMT + 3) / 4) * 4 * NT;
  for (int i = 0;; ++i) {
    const int idx = xsched_idx(i); if (idx >= TILES) break;
    int sm, nt; if (!gemm_tile(idx, SMT, NT, sm, nt)) continue;
    const int seq = sm / MT, mt = sm - seq * MT;
    const int seqbase = seq * SEQ, p0 = 254 * mt - 1;
    f32x16 acc[4][2]; zero_acc<4>(acc);
    gemm_dma<4>(acc, lds, H, DM, seqbase + p0, seqbase, seqbase + SEQ - 1, Wt, DM, 128 * nt, DFF + 128 * nt, DM);
    for (int hf = 0; hf < 2; ++hf) {
      LAS float* Cw = (LAS float*)lds;
      acc_to_lds_half(acc, lds, hf, hf);
      if (hf == 0 && wr == 1 && g == 0) {
#pragma unroll
        for (int ni = 0; ni < 2; ++ni) Cw[128 * CP + wc * 64 + ni * 32 + l32] = acc[0][ni][0];
      }
      if (hf == 1 && wr == 0 && g == 1) {
#pragma unroll
        for (int ni = 0; ni < 2; ++ni) Cw[wc * 64 + ni * 32 + l32] = acc[3][ni][15];
      }
      __syncthreads();
      const LAS float* Cs = (const LAS float*)lds;
#pragma unroll 1
      for (int k = 0; k < 4; ++k) {
        const int id = tid + 512 * k, lr = 1 + (id >> 4), ch = id & 15, pp = p0 + 127 * hf + lr;
        if (lr <= 127 && pp < SEQ) {
          const int c0 = 128 * nt + ch * 8;
          const float wp = pp > 0 ? 1.f : 0.f, wn = pp < SEQ - 1 ? 1.f : 0.f;
#pragma unroll 1
          for (int hh = 0; hh < 2; ++hh) {
            const f32x4 um = *(const LAS f32x4*)(Cs + (lr - 1) * CP + ch * 8 + 4 * hh), uc = *(const LAS f32x4*)(Cs + lr * CP + ch * 8 + 4 * hh),
                        un = *(const LAS f32x4*)(Cs + (lr + 1) * CP + ch * 8 + 4 * hh);
            const f32x4 w0 = *(const f32x4*)(cw + c0 + 4 * hh), w1 = *(const f32x4*)(cw + NUP + c0 + 4 * hh), w2 = *(const f32x4*)(cw + 2 * NUP + c0 + 4 * hh), bb = *(const f32x4*)(cb + c0 + 4 * hh);
            const f32x4 val = um * w0 * wp + uc * w1 + un * w2 * wn + bb;
            const f32x4 gm = *(const LAS f32x4*)(Cs + (lr - 1) * CP + 128 + ch * 8 + 4 * hh), gc = *(const LAS f32x4*)(Cs + lr * CP + 128 + ch * 8 + 4 * hh),
                        gn = *(const LAS f32x4*)(Cs + (lr + 1) * CP + 128 + ch * 8 + 4 * hh);
            const f32x4 v0 = *(const f32x4*)(cw + DFF + c0 + 4 * hh), v1 = *(const f32x4*)(cw + NUP + DFF + c0 + 4 * hh), v2 = *(const f32x4*)(cw + 2 * NUP + DFF + c0 + 4 * hh), vb = *(const f32x4*)(cb + DFF + c0 + 4 * hh);
            const f32x4 gt = gm * v0 * wp + gc * v1 + gn * v2 * wn + vb;
            u32x2 o; o.x = cvtpk(gelu_exact(gt.x) * val.x, gelu_exact(gt.y) * val.y); o.y = cvtpk(gelu_exact(gt.z) * val.z, gelu_exact(gt.w) * val.w);
            *(u32x2*)(ACT + (size_t)(seqbase + pp) * DFF + c0 + 4 * hh) = o;
          }
        }
      }
      __syncthreads();
    }
  }
}

#define XB_TMO      128
#define XB_XCNT(j)  (256  + 64 * (j))
#define XB_XSUB(j)  (1280 + 64 * (j))
#define XB_XGEN(j)  (2304 + 64 * (j))
#define XB_TOP      3328
#define XB_TOPGEN   3392
#define XCD_BAR_WORDS 3456
#define XB_SPIN_CAP (1u << 22)
DEVI unsigned xb_ld(unsigned* p)              { return __hip_atomic_load(p, __ATOMIC_RELAXED, __HIP_MEMORY_SCOPE_AGENT); }
DEVI unsigned xb_add(unsigned* p, unsigned v) { return __hip_atomic_fetch_add(p, v, __ATOMIC_RELAXED, __HIP_MEMORY_SCOPE_AGENT); }
DEVI unsigned xb_xcc_id() { return (unsigned)__builtin_amdgcn_s_getreg((3 << 11) | 20) & 0xFu; }
#define XB_SPIN(cond, bar) do { unsigned _sp = 0; while (cond) { __builtin_amdgcn_s_sleep(1); \
    if ((++_sp & 255u) == 0u) { if (xb_ld(&(bar)[XB_TMO])) break; if (_sp > XB_SPIN_CAP) { atomicAdd(&(bar)[XB_TMO], 1u); break; } } } } while (0)
struct XcdBarrier { unsigned* bar; unsigned x; volatile LAS unsigned* st; };
DEVI XcdBarrier xcd_barrier_post(unsigned* bar, volatile LAS unsigned* st) {
  XcdBarrier b; b.bar = bar; b.x = xb_xcc_id(); b.st = st;
  if (threadIdx.x == 0) (void)xb_add(&bar[XB_XCNT(b.x)], 1u);
  return b;
}
DEVI void xcd_barrier_complete(unsigned* bar, unsigned x, unsigned& nloc, unsigned& nx) {
  const unsigned G = gridDim.x * gridDim.y * gridDim.z;
  unsigned sum, cnt, mine, sp = 0u;
  for (;;) {
    sum = 0u; cnt = 0u; mine = 0u;
#pragma unroll
    for (unsigned j = 0; j < 16; ++j) { const unsigned c = xb_ld(&bar[XB_XCNT(j)]); sum += c; cnt += (c > 0u) ? 1u : 0u; mine = (j == x) ? c : mine; }
    if (sum == G) break;
    __builtin_amdgcn_s_sleep(1);
    if ((++sp & 255u) == 0u) { if (xb_ld(&bar[XB_TMO])) break; if (sp > XB_SPIN_CAP) { atomicAdd(&bar[XB_TMO], 1u); break; } }
  }
  nloc = mine > 0u ? mine : 1u; nx = cnt > 0u ? cnt : 1u;
}
DEVI void xcd_barrier(const XcdBarrier& b) {
  asm volatile("s_waitcnt vmcnt(0)" ::: "memory");
  __syncthreads();
  if (threadIdx.x == 0) {
    unsigned* bar = b.bar;
    __builtin_amdgcn_s_waitcnt(0);
    unsigned nloc = b.st[0], nx = b.st[1];
    if (nloc == 0u) { xcd_barrier_complete(bar, b.x, nloc, nx); b.st[0] = nloc; b.st[1] = nx; }
    const unsigned old = xb_add(&bar[XB_XSUB(b.x)], 1u);
    const unsigned gen = old / nloc;
    if (old + 1u == (gen + 1u) * nloc) {
      __builtin_amdgcn_fence(__ATOMIC_RELEASE, "agent");
      asm volatile("s_waitcnt vmcnt(0)" ::: "memory");
      const unsigned og = xb_add(&bar[XB_TOP], 1u);
      const unsigned tg = og / nx;
      if (og + 1u == (tg + 1u) * nx) xb_add(&bar[XB_TOPGEN], 1u);
      else XB_SPIN(xb_ld(&bar[XB_TOPGEN]) == tg, bar);
      __builtin_amdgcn_fence(__ATOMIC_ACQUIRE, "agent");
      xb_add(&bar[XB_XGEN(b.x)], 1u);
      asm volatile("s_waitcnt vmcnt(0)" ::: "memory");
    } else {
      XB_SPIN(xb_ld(&bar[XB_XGEN(b.x)]) == gen, bar);
      __builtin_amdgcn_fence(__ATOMIC_ACQUIRE, "agent");
      asm volatile("s_waitcnt vmcnt(0)" ::: "memory");
    }
  }
  __syncthreads();
}

constexpr int NPHASE = 17;
__global__ void __launch_bounds__(NTHR, 2) fwd_kernel(Params p) {
  __shared__ __attribute__((aligned(16))) char lds_raw[LDS_BYTES];
  __shared__ unsigned xb_state[2];
  lchar* lds = (lchar*)lds_raw;
  if (threadIdx.x < 2) xb_state[threadIdx.x] = 0u;
  __syncthreads();
  if (p.nseq == 12345) cg::this_grid().sync();
  const XcdBarrier xbar = xcd_barrier_post((unsigned*)(p.ws + WS_CTL), (volatile LAS unsigned*)xb_state);
#define GRID_SYNC() xcd_barrier(xbar)
  for (int i = 0; i < p.nseq; ++i) {
    if (i) GRID_SYNC();
    const int ph = (int)(((i < 12) ? (p.seq0 >> (5 * i)) : (p.seq1 >> (5 * (i - 12)))) & 31ull);
    if (ph == 0) { phase_weights(p, lds); phase_norm(p, 0, p.norm_attn); continue; }
    const int layer = (ph - 1) >> 3, sub = (ph - 1) & 7;
    switch (sub) {
      case 0: phase_qkv(p, layer, lds); break;
      case 1: phase_attn(p, layer, lds); break;
      case 2: phase_merge(p, layer, lds); break;
      case 3: phase_resid(p, p.out, (const bf16*)(p.ws + WS_QKV), DM, (const bf16*)(p.ws + WS_WOUT) + (size_t)layer * DM * DM, DM, lds, layer == 0); break;
      case 4: phase_norm(p, 1, p.norm_mlp + layer * DM); break;
      case 5: phase_up(p, layer, lds); break;
      case 6: phase_resid(p, p.out, (const bf16*)(p.ws + WS_QKV), DFF, (const bf16*)(p.ws + WS_WDN) + (size_t)layer * DM * DFF, DFF, lds, false); break;
      default: if (layer == 0) phase_norm(p, 1, p.norm_attn + DM); else phase_norm(p, 2, p.norm_final); break;
    }
  }
}

extern "C" void kernel_launch(void* const* d_in, const int* in_sizes, int n_in, void* d_out, int out_size, void* d_ws, size_t ws_size, hipStream_t stream) {
  static int grid = 0;
  if (grid == 0) {
    if (n_in != 16 || out_size != MTOK * DM || ws_size < WS_END) { fprintf(stderr, "kernel_launch: unexpected shapes (n_in %d out %d ws %zu need %zu)\n", n_in, out_size, ws_size, (size_t)WS_END); grid = -1; return; }
    int dev = 0, cus = 0, per_cu = 0;
    hipGetDevice(&dev);
    hipDeviceGetAttribute(&cus, hipDeviceAttributeMultiprocessorCount, dev);
    hipOccupancyMaxActiveBlocksPerMultiprocessor(&per_cu, fwd_kernel, NTHR, 0);
    if (per_cu < 1) per_cu = 1;
    if (per_cu > 1) per_cu = 1;
    grid = (cus * per_cu) & ~7;
    if (grid < 8) grid = -1;
  }
  if (grid < 0) return;
  Params p{};
  p.xp = (const float*)d_in[0]; p.xs = (const float*)d_in[1]; p.norm_attn = (const float*)d_in[2]; p.w_in = (const float*)d_in[3];
  p.diff_lambda = (const float*)d_in[4]; p.diff_subln = (const float*)d_in[5]; p.na_rpb = (const float*)d_in[6]; p.qk_norm = (const float*)d_in[7];
  p.w_branch = (const float*)d_in[8]; p.w_out = (const float*)d_in[9]; p.norm_mlp = (const float*)d_in[10]; p.w_up = (const float*)d_in[11];
  p.conv_w = (const float*)d_in[12]; p.conv_b = (const float*)d_in[13]; p.w_down = (const float*)d_in[14]; p.norm_final = (const float*)d_in[15];
  p.out = (float*)d_out; p.ws = (char*)d_ws;
  const double TWO_PI = 6.283185307179586476925286766559;
  for (int i = 0; i < 4; ++i) p.invA[i] = std::exp(-std::log(500000.0) * i / 4.0) / TWO_PI;
  for (int i = 0; i < 8; ++i) p.invC[i] = std::exp(-std::log(500000.0) * i / 8.0) / TWO_PI;
  for (int i = 0; i < 16; ++i) p.invD[i] = std::exp(-std::log(10000.0) * i / 16.0) / TWO_PI;
  for (int l = 0; l < 2; ++l) p.lam_init[l] = (float)(0.8 - 0.6 * std::exp(-0.3 * l));
  if (hipMemsetAsync((char*)d_ws + WS_CTL, 0, CTL_BYTES, stream) != hipSuccess) { fprintf(stderr, "kernel_launch: memset of barrier words failed\n"); return; }
  int codes[24]; int n = 0;
  for (int ph = 0; ph < NPHASE; ++ph) { codes[n++] = ph; if (ph > 0 && ((PROBE_DUP >> ((ph - 1) & 7)) & 1)) codes[n++] = ph; }
  p.nseq = n; p.seq0 = 0; p.seq1 = 0;
  for (int i = 0; i < n; ++i) { if (i < 12) p.seq0 |= (unsigned long long)codes[i] << (5 * i); else p.seq1 |= (unsigned long long)codes[i] << (5 * (i - 12)); }
  void* args[] = {&p};
  hipError_t e = hipLaunchCooperativeKernel((void*)fwd_kernel, dim3(grid), dim3(NTHR), args, 0, stream);
  if (e != hipSuccess) fprintf(stderr, "cooperative launch failed: %s (grid %d)\n", hipGetErrorString(e), grid);
}
```
